# Optimizing an MI355X kernel written in HIP

```python
import jax, jax.numpy as jnp
from jax import lax
import numpy as np

D_MODEL = 1024
BATCH = 1
SEQ = 16384
DEPTH = 2

D_CONF = 512
CONF_KERNEL = 31
D_SHORT = 512
SHORT_KERNEL = 3
D_FF_DENSE = 2816
N_EXPERTS = 8
TOP_K = 2
D_FF_EXPERT = 3584
RMS_EPS = 1e-6
LN_EPS = 1e-5
IN_COLS = 2 * D_CONF + 3 * D_SHORT + 2 * D_MODEL

kernel_name = "hybrid_conformer_shortconv_moe_trunk"


def rmsnorm(x, g):
    xf = x.astype(jnp.float32)
    y = xf * lax.rsqrt(jnp.mean(xf * xf, axis=-1, keepdims=True) + RMS_EPS)
    return (y * g.astype(jnp.float32)).astype(x.dtype)


def layernorm(x, g, b):
    xf = x.astype(jnp.float32)
    mu = jnp.mean(xf, axis=-1, keepdims=True)
    var = jnp.mean(jnp.square(xf - mu), axis=-1, keepdims=True)
    y = (xf - mu) * lax.rsqrt(var + LN_EPS)
    return (y * g.astype(jnp.float32) + b.astype(jnp.float32)).astype(x.dtype)


def causal_dwconv(x, w):
    k, c = w.shape
    return lax.conv_general_dilated(
        x, w[:, None, :].astype(x.dtype), window_strides=(1,), padding=[(k - 1, 0)],
        dimension_numbers=("NWC", "WIO", "NWC"), feature_group_count=c)


def token_mixer(h, w_in, conv_a, conv_a_bias, ln_a_g, ln_a_b, w_a, conv_b, w_b, w_o):
    z = h @ w_in
    splits = np.cumsum([D_CONF, D_CONF, D_SHORT, D_SHORT, D_SHORT, D_MODEL]).tolist()
    a_val, a_gate, s_b, s_c, s_x, g_a, g_b = jnp.split(z, splits, axis=-1)
    a = a_val * jax.nn.sigmoid(a_gate)
    a = causal_dwconv(a, conv_a) + conv_a_bias
    a = jax.nn.silu(layernorm(a, ln_a_g, ln_a_b))
    y_a = a @ w_a
    u = causal_dwconv(s_c * s_x, conv_b)
    y_b = (s_b * u) @ w_b
    merged = jax.nn.sigmoid(g_a) * y_a + jax.nn.sigmoid(g_b) * y_b
    return merged @ w_o


def swiglu(h, w1, w3, w2):
    return (jax.nn.silu(h @ w1) * (h @ w3)) @ w2


def moe_ffn(h, router, we1, we3, we2):
    logits = (h @ router).astype(jnp.float32)
    top_vals, top_idx = lax.top_k(logits, TOP_K)
    top_w = jax.nn.softmax(top_vals, axis=-1)
    combine = jnp.sum(jax.nn.one_hot(top_idx, N_EXPERTS, dtype=jnp.float32) * top_w[..., None], axis=-2)
    combine = combine.astype(h.dtype)
    out = jnp.zeros_like(h)
    for e in range(N_EXPERTS):
        out = out + combine[..., e:e + 1] * swiglu(h, we1[e], we3[e], we2[e])
    return out


def setup_inputs(seed: int = 0) -> dict:
    key = jax.random.key(seed)
    keys = iter(jax.random.split(key, 64))
    nrm = lambda shape, scale: jax.random.normal(next(keys), shape, jnp.float32) * scale
    gain = lambda n: 1.0 + nrm((n,), 0.02)
    inp = {"x": nrm((BATCH, SEQ, D_MODEL), 1.0)}
    for l in range(DEPTH):
        p = f"l{l}_"
        inp[p + "norm1"] = gain(D_MODEL)
        inp[p + "w_in"] = nrm((D_MODEL, IN_COLS), D_MODEL ** -0.5)
        inp[p + "conv_a"] = nrm((CONF_KERNEL, D_CONF), CONF_KERNEL ** -0.5)
        inp[p + "conv_a_bias"] = nrm((D_CONF,), 0.02)
        inp[p + "ln_a_g"] = gain(D_CONF)
        inp[p + "ln_a_b"] = nrm((D_CONF,), 0.02)
        inp[p + "w_a"] = nrm((D_CONF, D_MODEL), D_CONF ** -0.5)
        inp[p + "conv_b"] = nrm((SHORT_KERNEL, D_SHORT), SHORT_KERNEL ** -0.5)
        inp[p + "w_b"] = nrm((D_SHORT, D_MODEL), D_SHORT ** -0.5)
        inp[p + "w_o"] = nrm((D_MODEL, D_MODEL), D_MODEL ** -0.5)
        inp[p + "norm2"] = gain(D_MODEL)
        if l % 2 == 0:
            inp[p + "ffn_w1"] = nrm((D_MODEL, D_FF_DENSE), D_MODEL ** -0.5)
            inp[p + "ffn_w3"] = nrm((D_MODEL, D_FF_DENSE), D_MODEL ** -0.5)
            inp[p + "ffn_w2"] = nrm((D_FF_DENSE, D_MODEL), D_FF_DENSE ** -0.5)
        else:
            inp[p + "router"] = nrm((D_MODEL, N_EXPERTS), D_MODEL ** -0.5)
            inp[p + "moe_w1"] = nrm((N_EXPERTS, D_MODEL, D_FF_EXPERT), D_MODEL ** -0.5)
            inp[p + "moe_w3"] = nrm((N_EXPERTS, D_MODEL, D_FF_EXPERT), D_MODEL ** -0.5)
            inp[p + "moe_w2"] = nrm((N_EXPERTS, D_FF_EXPERT, D_MODEL), D_FF_EXPERT ** -0.5)
    inp["final_norm"] = gain(D_MODEL)
    return inp


def reference(x,
              l0_norm1, l0_w_in, l0_conv_a, l0_conv_a_bias, l0_ln_a_g, l0_ln_a_b, l0_w_a, l0_conv_b, l0_w_b, l0_w_o,
              l0_norm2, l0_ffn_w1, l0_ffn_w3, l0_ffn_w2,
              l1_norm1, l1_w_in, l1_conv_a, l1_conv_a_bias, l1_ln_a_g, l1_ln_a_b, l1_w_a, l1_conv_b, l1_w_b, l1_w_o,
              l1_norm2, l1_router, l1_moe_w1, l1_moe_w3, l1_moe_w2,
              final_norm):
    mixer_params = [
        (l0_w_in, l0_conv_a, l0_conv_a_bias, l0_ln_a_g, l0_ln_a_b, l0_w_a, l0_conv_b, l0_w_b, l0_w_o),
        (l1_w_in, l1_conv_a, l1_conv_a_bias, l1_ln_a_g, l1_ln_a_b, l1_w_a, l1_conv_b, l1_w_b, l1_w_o),
    ]
    norm1 = [l0_norm1, l1_norm1]
    norm2 = [l0_norm2, l1_norm2]
    dense_params = [(l0_ffn_w1, l0_ffn_w3, l0_ffn_w2)]
    moe_params = [(l1_router, l1_moe_w1, l1_moe_w3, l1_moe_w2)]
    for layer in range(DEPTH):
        x = x + token_mixer(rmsnorm(x, norm1[layer]), *mixer_params[layer])
        h = rmsnorm(x, norm2[layer])
        if layer % 2 == 0:
            x = x + swiglu(h, *dense_params[layer // 2])
        else:
            x = x + moe_ffn(h, *moe_params[layer // 2])
    return rmsnorm(x, final_norm)
```

```cpp
#include <hip/hip_runtime.h>
#include <cstdio>
#include <cstdint>

#ifndef MK_PER_PHASE
#define MK_PER_PHASE 0
#endif

namespace pg8 {
#define PG8_LAS __attribute__((address_space(3)))
#define PG8_GAS __attribute__((address_space(1)))
typedef unsigned short bf16_t;
typedef short bf16x8 __attribute__((ext_vector_type(8)));
typedef float f32x4 __attribute__((ext_vector_type(4)));
typedef unsigned u32x4 __attribute__((ext_vector_type(4)));
typedef unsigned u32x2 __attribute__((ext_vector_type(2)));
typedef int v4i_t __attribute__((ext_vector_type(4)));
typedef int v8i_t __attribute__((ext_vector_type(8)));
constexpr int BM = 256, BK = 64, HALF = 128, HTB = HALF * BK * 2  , STAGE_BYTES = 8 * HTB, NXCD = 8, WGM = 8;

__host__ __device__ __forceinline__ int lds_byte(int r, int c) { const int st = (r >> 4) * 2 + (c >> 5), rr = r & 15, cc = c & 31, ob = rr * 64 + cc * 2; return st * 1024 + (ob ^ (((ob >> 9) & 1) << 5)); }
__host__ __device__ __forceinline__ void stage_rc(int b, int& R, int& C) { const int st = b / 1024, sb = b % 1024, swz = sb ^ (((sb >> 9) & 1) << 5); R = (st >> 1) * 16 + swz / 64; C = (st & 1) * 32 + (swz % 64) / 2; }
__host__ __device__ __forceinline__ int perm32(int rho) { const int n = rho >> 4, i = rho & 15; return 8 * (i >> 2) + 4 * n + (i & 3); }

struct Unit { int pa, pn, bn, po, koff; };
struct NoPre {};
struct Gemm { const bf16_t* A; const bf16_t* Bt; int K, pitch; };

struct StaticOrder {
    int nM, nN, nwg, G, c, pn0;
    __device__ __forceinline__ void init(int nM_, int nN_, int G_, int c_, int pn0_ = 0) { nM = nM_; nN = nN_; nwg = nM * nN; G = G_; c = c_; pn0 = pn0_; }
    __device__ __forceinline__ bool next(int i, Unit& u) const {
        const long L = (long)i * G + c; if (L >= nwg) return false;
        int wgid = (int)L; { const int q = nwg / NXCD, r = nwg % NXCD, xcd = wgid % NXCD, off = wgid / NXCD; wgid = (xcd < r ? xcd * (q + 1) : r * (q + 1) + (xcd - r) * q) + off; }
        const int nig = WGM * nN, gid = wgid / nig, fm = gid * WGM, gsz = (nM - fm) < WGM ? (nM - fm) : WGM;
        u.pa = fm + ((wgid % nig) % gsz); u.pn = pn0 + (wgid % nig) / gsz; u.bn = u.pn; u.po = u.pa; u.koff = 0; return true;
    }
};
template <bool UP> struct MoeOrder {
    int p_lo, np, nN, nwg, G, c; int ps[9];
    __device__ __forceinline__ bool next(int i, Unit& u) const {
        const long L = (long)i * G + c; if (L >= nwg) return false;
        int wgid = (int)L; { const int q = nwg / NXCD, r = nwg % NXCD, xcd = wgid % NXCD, off = wgid / NXCD; wgid = (xcd < r ? xcd * (q + 1) : r * (q + 1) + (xcd - r) * q) + off; }
        const int nig = WGM * nN, gid = wgid / nig, fm = gid * WGM, gsz = (np - fm) < WGM ? (np - fm) : WGM;
        const int pl = fm + ((wgid % nig) % gsz), pn = (wgid % nig) / gsz, p = p_lo + pl;
        int e = 0;
#pragma unroll
        for (int j = 1; j < 8; ++j) e += (ps[j] <= p) ? 1 : 0;
        u.pn = pn; u.bn = e * nN + pn; u.pa = UP ? p : pl; u.po = UP ? pl : p; u.koff = 0; return true;
    }
};

typedef __bf16 bf16v2_t __attribute__((ext_vector_type(2)));
typedef float f32v2_t __attribute__((ext_vector_type(2)));
constexpr int TAIL_P0 = 128, TAIL_NKS = 7;
struct MoeTailOrder {
    int ntail, G, c; int ps[9];
    __device__ __forceinline__ bool next(int i, Unit& u) const {
        const long L = (long)i * G + c; if (L >= (long)ntail * 4 * TAIL_NKS) return false;
        const int ks = (int)L % TAIL_NKS, tile = (int)L / TAIL_NKS, pl = tile >> 2, pn = tile & 3, p = TAIL_P0 + pl;
        int e = 0;
#pragma unroll
        for (int j = 1; j < 8; ++j) e += (ps[j] <= p) ? 1 : 0;
        u.pa = p; u.pn = pn; u.bn = e * 4 + pn; u.po = ks * 8 + pl; u.koff = ks * 512; return true;
    }
};

__device__ __forceinline__ unsigned cvt_pk_bf16(float lo, float hi) { const f32v2_t f = {lo, hi}; const bf16v2_t b = __builtin_convertvector(f, bf16v2_t); return __builtin_bit_cast(unsigned, b); }
__device__ __forceinline__ float bflo(unsigned w) { return __uint_as_float(w << 16); }
__device__ __forceinline__ float bfhi(unsigned w) { return __uint_as_float(w & 0xffff0000u); }
__device__ __forceinline__ float sigmoid_f(float x) { return __builtin_amdgcn_rcpf(1.0f + __builtin_amdgcn_exp2f(-1.4426950408889634f * x)); }
__device__ __forceinline__ u32x4 pack8(const f32x4& a, const f32x4& b) { u32x4 w; w.x = cvt_pk_bf16(a[0], a[1]); w.y = cvt_pk_bf16(a[2], a[3]); w.z = cvt_pk_bf16(b[0], b[1]); w.w = cvt_pk_bf16(b[2], b[3]); return w; }
__device__ __forceinline__ unsigned pk4_fp8(float a, float b, float c, float d) {
    a = __builtin_amdgcn_fmed3f(a, -448.f, 448.f); b = __builtin_amdgcn_fmed3f(b, -448.f, 448.f); c = __builtin_amdgcn_fmed3f(c, -448.f, 448.f); d = __builtin_amdgcn_fmed3f(d, -448.f, 448.f);
    int w = 0; w = __builtin_amdgcn_cvt_pk_fp8_f32(a, b, w, false); w = __builtin_amdgcn_cvt_pk_fp8_f32(c, d, w, true); return (unsigned)w; }
__device__ __forceinline__ void unpack8(const u32x4& w, f32x4& a, f32x4& b) { a[0] = bflo(w.x); a[1] = bfhi(w.x); a[2] = bflo(w.y); a[3] = bfhi(w.y); b[0] = bflo(w.z); b[1] = bfhi(w.z); b[2] = bflo(w.w); b[3] = bfhi(w.w); }
__device__ __forceinline__ void rows_rstd(const float* ss, int row0, int fq, float (&rs)[2][4]) {
    f32x4 pv[2][4];
#pragma unroll
    for (int ai = 0; ai < 2; ++ai)
#pragma unroll
        for (int m = 0; m < 4; ++m) pv[ai][m] = *(const f32x4*)(ss + (size_t)(row0 + ai * HALF + m * 16) * 16 + 4 * fq);
#pragma unroll
    for (int ai = 0; ai < 2; ++ai)
#pragma unroll
        for (int m = 0; m < 4; ++m) { const f32x4 v = pv[ai][m]; float s = (v[0] + v[1]) + (v[2] + v[3]); s += __shfl_xor(s, 16); s += __shfl_xor(s, 32); rs[ai][m] = __builtin_amdgcn_rsqf(s * (1.0f / 1024.0f) + 1e-6f); }
}

__device__ __forceinline__ void rows_rstd_lds(const PG8_LAS float* tab, int pa0, const float* ss, const Unit& u, int wr, int fr, int fq, float (&rs)[2][4]) {
    if (u.po == pa0) {
#pragma unroll
        for (int ai = 0; ai < 2; ++ai)
#pragma unroll
            for (int m = 0; m < 4; ++m) rs[ai][m] = tab[wr * 64 + fr + ai * HALF + m * 16];
    } else rows_rstd(ss, u.po * BM + wr * 64 + fr, fq, rs);
}

template <int PART> struct EpiG1 {
    static constexpr bool HAS_MID = false, ACC_INIT = false;
    const float* ss; bf16_t *a, *v, *sb, *R, *Gt; const PG8_LAS float* rtab; int pa0;
    typedef NoPre Pre; __device__ __forceinline__ void pre(NoPre&, const Unit&, int, int) const {}
    __device__ __forceinline__ void mid(f32x4 (&)[2][2][4][2], const Unit&, int, int, int, int) const {}
    __device__ __forceinline__ void operator()(const f32x4 (&acc)[2][2][4][2], const Unit& u, int wr, int wc, int fr, int fq, const NoPre&) const {
        const int row0 = u.po * BM + wr * 64 + fr, cw = wc * 32 + 8 * fq, pn = u.pn;
        float rsv[2][4]; rows_rstd_lds(rtab, pa0, ss, u, wr, fr, fq, rsv);
#pragma unroll
        for (int ai = 0; ai < 2; ++ai)
#pragma unroll
            for (int m = 0; m < 4; ++m) {
                const int row = row0 + ai * HALF + m * 16;
                const float rs = rsv[ai][m];
                const float rsn = rs * -1.4426950408889634f, rs2 = rs * rs;
                if (PART == 0 && pn < 4) {
                    f32x4 o[2];
#pragma unroll
                    for (int hh = 0; hh < 2; ++hh)
#pragma unroll
                        for (int j = 0; j < 4; j += 2) { const f32x4& a1 = acc[ai][0][m][hh]; const f32x4& a2 = acc[ai][1][m][hh];
                            const f32v2_t av = {a1[j], a1[j + 1]}, gv = {a2[j], a2[j + 1]}; const f32v2_t pe = gv * rsn;
                            f32v2_t e; e.x = __builtin_amdgcn_exp2f(pe.x); e.y = __builtin_amdgcn_exp2f(pe.y); const f32v2_t d = e + 1.0f;
                            f32v2_t r; r.x = __builtin_amdgcn_rcpf(d.x); r.y = __builtin_amdgcn_rcpf(d.y); const f32v2_t ov = (av * rs) * r; o[hh][j] = ov.x; o[hh][j + 1] = ov.y; }
                    *(u32x4*)(a + (size_t)row * 512 + pn * 128 + cw) = pack8(o[0], o[1]);
                } else if (PART == 0 && pn < 8) {
                    *(u32x4*)(v + (size_t)row * 512 + (pn - 4) * 128 + cw) = pack8((acc[ai][0][m][0] * acc[ai][1][m][0]) * rs2, (acc[ai][0][m][1] * acc[ai][1][m][1]) * rs2);
                } else if (PART == 0) {
                    bf16_t* d = sb + (size_t)row * 512 + (pn - 8) * 256 + cw;
                    *(u32x4*)d = pack8(acc[ai][0][m][0] * rs, acc[ai][0][m][1] * rs); *(u32x4*)(d + 128) = pack8(acc[ai][1][m][0] * rs, acc[ai][1][m][1] * rs);
                } else {
                    f32x4 rr[2], gg[2];
#pragma unroll
                    for (int hh = 0; hh < 2; ++hh)
#pragma unroll
                        for (int j = 0; j < 4; j += 2) { const f32x4& a1 = acc[ai][0][m][hh]; const f32x4& a2 = acc[ai][1][m][hh];
                            f32v2_t ga = (f32v2_t){a1[j], a1[j + 1]} * rs, gb = (f32v2_t){a2[j], a2[j + 1]} * rs;
                            ga.x = __builtin_amdgcn_fmed3f(ga.x, -80.f, 80.f); ga.y = __builtin_amdgcn_fmed3f(ga.y, -80.f, 80.f); gb.x = __builtin_amdgcn_fmed3f(gb.x, -80.f, 80.f); gb.y = __builtin_amdgcn_fmed3f(gb.y, -80.f, 80.f);
                            const f32v2_t pa = ga * -1.4426950408889634f, pb = gb * -1.4426950408889634f;
                            f32v2_t ea, eb; ea.x = __builtin_amdgcn_exp2f(pa.x); ea.y = __builtin_amdgcn_exp2f(pa.y); eb.x = __builtin_amdgcn_exp2f(pb.x); eb.y = __builtin_amdgcn_exp2f(pb.y);
                            const f32v2_t da = ea + 1.0f, db = eb + 1.0f;
                            f32v2_t ia, ib; ia.x = __builtin_amdgcn_rcpf(da.x); ia.y = __builtin_amdgcn_rcpf(da.y); ib.x = __builtin_amdgcn_rcpf(db.x); ib.y = __builtin_amdgcn_rcpf(db.y);
                            const f32v2_t rv = db * ia; rr[hh][j] = rv.x; rr[hh][j + 1] = rv.y; gg[hh][j] = ib.x; gg[hh][j + 1] = ib.y; }
                    const size_t o = (size_t)row * 1024 + (pn - 10) * 128 + cw;
                    *(u32x4*)(R + o) = pack8(rr[0], rr[1]); *(u32x4*)(Gt + o) = pack8(gg[0], gg[1]);
                }
            }
    }
};
struct EpiG2 {
    static constexpr bool HAS_MID = true, ACC_INIT = false;
    const bf16_t *R, *Gt; bf16_t* out;
    typedef NoPre Pre; __device__ __forceinline__ void pre(NoPre&, const Unit&, int, int) const {}
    __device__ __forceinline__ void mid(f32x4 (&acc)[2][2][4][2], const Unit& u, int wr, int wc, int fr, int fq) const {
        int po_ = u.po; asm volatile("" : "+s"(po_));
        const int row0 = po_ * BM + wr * 64 + fr, cw = u.pn * BM + wc * 32 + 8 * fq;
#pragma unroll
        for (int ai = 0; ai < 2; ++ai) {
            u32x4 gv[4][2];
#pragma unroll
            for (int m = 0; m < 4; ++m)
#pragma unroll
                for (int bj = 0; bj < 2; ++bj) gv[m][bj] = *(const u32x4*)(R + (size_t)(row0 + ai * HALF + m * 16) * 1024 + cw + bj * HALF);
#pragma unroll
            for (int m = 0; m < 4; ++m)
#pragma unroll
                for (int bj = 0; bj < 2; ++bj) { f32x4 g0, g1; unpack8(gv[m][bj], g0, g1); acc[ai][bj][m][0] *= g0; acc[ai][bj][m][1] *= g1; }
            asm volatile("" ::: "memory");
        }
    }
    __device__ __forceinline__ void operator()(const f32x4 (&acc)[2][2][4][2], const Unit& u, int wr, int wc, int fr, int fq, const NoPre&) const {
        int po_ = u.po; asm volatile("" : "+s"(po_));
        const int row0 = po_ * BM + wr * 64 + fr, cw = u.pn * BM + wc * 32 + 8 * fq;
#pragma unroll
        for (int ai = 0; ai < 2; ++ai) {
            u32x4 gv[4][2];
#pragma unroll
            for (int m = 0; m < 4; ++m)
#pragma unroll
                for (int bj = 0; bj < 2; ++bj) gv[m][bj] = *(const u32x4*)(Gt + (size_t)(row0 + ai * HALF + m * 16) * 1024 + cw + bj * HALF);
#pragma unroll
            for (int m = 0; m < 4; ++m)
#pragma unroll
                for (int bj = 0; bj < 2; ++bj) { f32x4 g0, g1; unpack8(gv[m][bj], g0, g1);
                    *(u32x4*)(out + (size_t)(row0 + ai * HALF + m * 16) * 1024 + cw + bj * HALF) = pack8(acc[ai][bj][m][0] * g0, acc[ai][bj][m][1] * g1); }
            asm volatile("" ::: "memory");
        }
    }
};
template <bool AUX, bool XF32> struct EpiRes {
    static constexpr bool HAS_MID = false, ACC_INIT = true;
    const float* xin; bf16_t* xb; float* ss;
    typedef NoPre Pre; __device__ __forceinline__ void pre(NoPre&, const Unit&, int, int) const {}
    __device__ __forceinline__ void mid(f32x4 (&)[2][2][4][2], const Unit&, int, int, int, int) const {}
    __device__ __forceinline__ void init(f32x4 (&acc)[2][2][4][2], const Unit& u, int wr, int wc, int fr, int fq) const {
        const int row0 = u.po * BM + wr * 64 + fr, cw = u.pn * BM + wc * 32 + 8 * fq;
#pragma unroll
        for (int ai = 0; ai < 2; ++ai)
#pragma unroll
            for (int m = 0; m < 4; ++m)
#pragma unroll
                for (int bj = 0; bj < 2; ++bj) { const size_t o = (size_t)(row0 + ai * HALF + m * 16) * 1024 + cw + bj * HALF;
                    if (XF32) { acc[ai][bj][m][0] = *(const f32x4*)(xin + o); acc[ai][bj][m][1] = *(const f32x4*)(xin + o + 4); }
                    else unpack8(*(const u32x4*)(xb + o), acc[ai][bj][m][0], acc[ai][bj][m][1]); }
    }
    __device__ __forceinline__ void operator()(const f32x4 (&acc)[2][2][4][2], const Unit& u, int wr, int wc, int fr, int fq, const NoPre&) const {
        const int row0 = u.po * BM + wr * 64 + fr, cw = u.pn * BM + wc * 32 + 8 * fq;
#pragma unroll
        for (int ai = 0; ai < 2; ++ai)
#pragma unroll
            for (int m = 0; m < 4; ++m) {
                const int row = row0 + ai * HALF + m * 16; const size_t o = (size_t)row * 1024 + cw; float q = 0.f;
#pragma unroll
                for (int bj = 0; bj < 2; ++bj) {
                    const f32x4 o0 = acc[ai][bj][m][0], o1 = acc[ai][bj][m][1];
                    if (AUX) q += (o0[0] * o0[0] + o0[1] * o0[1]) + (o0[2] * o0[2] + o0[3] * o0[3]) + (o1[0] * o1[0] + o1[1] * o1[1]) + (o1[2] * o1[2] + o1[3] * o1[3]);
                    *(u32x4*)(xb + o + bj * HALF) = pack8(o0, o1);
                }
                if (AUX) { q += __shfl_xor(q, 16); q += __shfl_xor(q, 32); if (fq == 0) ss[(size_t)row * 16 + u.pn * 4 + wc] = q; }
            }
    }
};
constexpr float F8_WSCALE = 64.0f, F8_WINV = 1.0f / 64.0f;
template <bool MOE> struct EpiUp {
    static constexpr bool HAS_MID = false, ACC_INIT = false;
    const float* rsrc; void* hid; int ld; const PG8_LAS float* rtab; int pa0;
    struct Pre { float rs[2][4]; };
    __device__ __forceinline__ void pre(Pre& pf, const Unit& u, int wr, int fr) const {
        if (MOE) { const int row0 = u.po * BM + wr * 64 + fr;
#pragma unroll
            for (int ai = 0; ai < 2; ++ai)
#pragma unroll
                for (int m = 0; m < 4; ++m) pf.rs[ai][m] = rsrc[row0 + ai * HALF + m * 16]; } }
    __device__ __forceinline__ void mid(f32x4 (&)[2][2][4][2], const Unit&, int, int, int, int) const {}
    __device__ __forceinline__ void operator()(const f32x4 (&acc)[2][2][4][2], const Unit& u, int wr, int wc, int fr, int fq, const Pre& pf) const {
        const int row0 = u.po * BM + wr * 64 + fr, cw = u.pn * HALF + wc * 32 + 8 * fq;
        float rsv[2][4];
        if (MOE) {
#pragma unroll
            for (int ai = 0; ai < 2; ++ai)
#pragma unroll
                for (int m = 0; m < 4; ++m) rsv[ai][m] = pf.rs[ai][m] * F8_WINV;
        } else rows_rstd_lds(rtab, pa0, rsrc, u, wr, fr, fq, rsv);
#pragma unroll
        for (int ai = 0; ai < 2; ++ai)
#pragma unroll
            for (int m = 0; m < 4; ++m) {
                const int row = row0 + ai * HALF + m * 16;
                const float rs = rsv[ai][m];
                const float rsn = rs * -1.4426950408889634f, rs2 = rs * rs;
                f32x4 o0, o1;
#pragma unroll
                for (int hh = 0; hh < 2; ++hh)
#pragma unroll
                    for (int j = 0; j < 4; j += 2) {
                        const f32x4& a1 = acc[ai][0][m][hh]; const f32x4& a3 = acc[ai][1][m][hh];
                        const f32v2_t av = {a1[j], a1[j + 1]}, bv = {a3[j], a3[j + 1]};
                        const f32v2_t pe = av * rsn, pq = (av * bv) * rs2;
                        f32v2_t e; e.x = __builtin_amdgcn_exp2f(pe.x); e.y = __builtin_amdgcn_exp2f(pe.y);
                        const f32v2_t d = e + 1.0f; f32v2_t r; r.x = __builtin_amdgcn_rcpf(d.x); r.y = __builtin_amdgcn_rcpf(d.y);
                        const f32v2_t o = pq * r;
                        if (hh == 0) { o0[j] = o.x; o0[j + 1] = o.y; } else { o1[j] = o.x; o1[j + 1] = o.y; }
                    }
                if (MOE) { u32x2 w; w.x = pk4_fp8(o0[0], o0[1], o0[2], o0[3]); w.y = pk4_fp8(o1[0], o1[1], o1[2], o1[3]); *(u32x2*)((unsigned char*)hid + (size_t)row * ld + cw) = w; }
                else *(u32x4*)((bf16_t*)hid + (size_t)row * ld + cw) = pack8(o0, o1);
            }
    }
};
constexpr float Y8_SCALE = 16.0f, Y8_INV = 1.0f / 16.0f;
template <bool TAIL> struct EpiDownMoeT {
    static constexpr bool HAS_MID = false, ACC_INIT = false;
    const float* w; unsigned char* Y;
    struct Pre { float ws[2][4]; };
    __device__ __forceinline__ void pre(Pre& pf, const Unit& u, int wr, int fr) const {
        const int row0 = u.po * BM + wr * 64 + fr;
#pragma unroll
        for (int ai = 0; ai < 2; ++ai)
#pragma unroll
            for (int m = 0; m < 4; ++m) { const int row = row0 + ai * HALF + m * 16; pf.ws[ai][m] = w[TAIL ? row - (u.po - (u.po & 7)) * BM + TAIL_P0 * BM : row]; } }
    __device__ __forceinline__ void mid(f32x4 (&)[2][2][4][2], const Unit&, int, int, int, int) const {}
    __device__ __forceinline__ void operator()(const f32x4 (&acc)[2][2][4][2], const Unit& u, int wr, int wc, int fr, int fq, const Pre& pf) const {
        const int row0 = u.po * BM + wr * 64 + fr, cw = u.pn * BM + wc * 32 + 8 * fq;
#pragma unroll
        for (int ai = 0; ai < 2; ++ai)
#pragma unroll
            for (int m = 0; m < 4; ++m) {
                const int row = row0 + ai * HALF + m * 16; const float ws = pf.ws[ai][m] * (F8_WINV * Y8_SCALE); const size_t o = (size_t)row * 1024 + cw;
#pragma unroll
                for (int bj = 0; bj < 2; ++bj) { const f32x4 v0 = acc[ai][bj][m][0] * ws, v1 = acc[ai][bj][m][1] * ws; u32x2 pk; pk.x = pk4_fp8(v0[0], v0[1], v0[2], v0[3]); pk.y = pk4_fp8(v1[0], v1[1], v1[2], v1[3]); *(u32x2*)(Y + o + bj * HALF) = pk; }
            }
    }
};

template <class Epi, class Sched, bool ALIGN_EPI = false, bool SP2 = false, bool F8 = false>
__device__ __forceinline__ void gemm_phase(PG8_LAS unsigned char* lds, const Gemm g, const Sched& S, const Epi& E) {
    int tid_ = threadIdx.x; asm volatile("" : "+v"(tid_));
    const int tid = tid_, wid = __builtin_amdgcn_readfirstlane(tid >> 6), lane = tid & 63, wr = wid >> 2, wc = wid & 3, fr = lane & 15, fq = lane >> 4;
    const int K = g.pitch, nt = g.K / BK;
    unsigned voffA[2], voffB[2];
#pragma unroll
    for (int i = 0; i < 2; ++i) { int R, C; stage_rc(tid * 16 + i * 8192, R, C); const int Rb = (R & ~31) + perm32(R & 31);
        voffA[i] = (unsigned)(R * K + C) * 2u; voffB[i] = (unsigned)(Rb * K + C) * 2u; }
    const size_t kstep = (size_t)(BK * 2);
    const size_t hstep = (size_t)HALF * K * 2;
    const size_t tstep = 2 * hstep;
    const unsigned ldsw = (unsigned)wid * 1024u;
    const int aoff = lds_byte(wr * 64 + fr, fq * 8), boff = lds_byte(wc * 32 + fr, fq * 8);
#define PG8_SA(b, h) (((b) * 2 + (h)) * HTB)
#define PG8_SB(b, h) ((4 + (b) * 2 + (h)) * HTB)
#define PG8_STAGE(bufoff, gbase, voff) do { _Pragma("unroll") for (int _i = 0; _i < 2; ++_i) \
        __builtin_amdgcn_global_load_lds((const PG8_GAS unsigned*)((gbase) + (voff)[_i]), (PG8_LAS unsigned*)(lds + (bufoff) + ldsw + _i * 8192), 16, 0, 0); } while (0)
#define PG8_LDA(dst, b, h) do { _Pragma("unroll") for (int m = 0; m < 4; ++m) _Pragma("unroll") for (int k = 0; k < 2; ++k) dst[m][k] = *(const PG8_LAS bf16x8*)(lds + PG8_SA(b, h) + aoff + m * 2048 + k * 1024); } while (0)
#define PG8_LDB(dst, b, h) do { _Pragma("unroll") for (int n = 0; n < 2; ++n) _Pragma("unroll") for (int k = 0; k < 2; ++k) dst[n][k] = *(const PG8_LAS bf16x8*)(lds + PG8_SB(b, h) + boff + n * 2048 + k * 1024); } while (0)
#define PG8_MMA(ai, bj, At, Bt) do { __builtin_amdgcn_s_setprio(1); if constexpr (F8) { _Pragma("unroll") for (int m = 0; m < 4; ++m) _Pragma("unroll") for (int n = 0; n < 2; ++n) { \
            const v8i_t a8 = __builtin_shufflevector(__builtin_bit_cast(v4i_t, At[m][0]), __builtin_bit_cast(v4i_t, At[m][1]), 0, 1, 2, 3, 4, 5, 6, 7), b8 = __builtin_shufflevector(__builtin_bit_cast(v4i_t, Bt[n][0]), __builtin_bit_cast(v4i_t, Bt[n][1]), 0, 1, 2, 3, 4, 5, 6, 7); \
            asm volatile("v_mfma_scale_f32_16x16x128_f8f6f4 %0, %1, %2, %0, %3, %3 op_sel_hi:[0,0,0]" : "+v"(acc[ai][bj][m][n]) : "v"(b8), "v"(a8), "v"(f8_unit_scale)); } } else { \
        _Pragma("unroll") for (int m = 0; m < 4; ++m) _Pragma("unroll") for (int n = 0; n < 2; ++n) _Pragma("unroll") for (int k = 0; k < 2; ++k) \
        acc[ai][bj][m][n] = __builtin_amdgcn_mfma_f32_16x16x32_bf16(Bt[n][k], At[m][k], acc[ai][bj][m][n], 0, 0, 0); } __builtin_amdgcn_s_setprio(0); } while (0)
#define PG8_WAIT_V(n) asm volatile("s_waitcnt vmcnt(" #n ")" ::: "memory")
#define PG8_WAIT_L(n) asm volatile("s_waitcnt lgkmcnt(" #n ")" ::: "memory")
#define PG8_BAR __builtin_amdgcn_s_barrier()
#define PG8_SCHED __builtin_amdgcn_sched_barrier(0)
    Unit cur, nxt; int ui = 0;
    if (!S.next(0, cur)) return;
    cur.pa = __builtin_amdgcn_readfirstlane(cur.pa); cur.pn = __builtin_amdgcn_readfirstlane(cur.pn); cur.bn = __builtin_amdgcn_readfirstlane(cur.bn); cur.po = __builtin_amdgcn_readfirstlane(cur.po); cur.koff = __builtin_amdgcn_readfirstlane(cur.koff);
    f32x4 acc[2][2][4][2];
    typename Epi::Pre pf;
    const int f8_unit_scale = 0x7F7F7F7F;
    (void)f8_unit_scale;
    if constexpr (Epi::ACC_INIT) E.init(acc, cur, wr, wc, fr, fq);
    else {
#pragma unroll
    for (int a = 0; a < 2; ++a)
#pragma unroll
        for (int b = 0; b < 2; ++b)
#pragma unroll
            for (int m = 0; m < 4; ++m)
#pragma unroll
                for (int n = 0; n < 2; ++n) acc[a][b][m][n] = (f32x4){0.f, 0.f, 0.f, 0.f};
    }
    bf16x8 At[4][2], B0[2][2], B1[2][2];
    const PG8_GAS char* cA = (const PG8_GAS char*)g.A + (size_t)cur.pa * tstep + cur.koff; const PG8_GAS char* cB = (const PG8_GAS char*)g.Bt + (size_t)cur.bn * tstep + cur.koff;
    if constexpr (SP2) {
        PG8_STAGE(PG8_SB(0, 0), cB, voffB); PG8_STAGE(PG8_SB(0, 1), cB + hstep, voffB); PG8_STAGE(PG8_SA(0, 0), cA, voffA); PG8_STAGE(PG8_SA(0, 1), cA + hstep, voffA);
        if (wr == 1) PG8_BAR;
        PG8_WAIT_V(2); PG8_BAR;
        PG8_STAGE(PG8_SB(1, 0), cB + kstep, voffB); PG8_STAGE(PG8_SA(1, 0), cA + kstep, voffA); PG8_STAGE(PG8_SB(1, 1), cB + hstep + kstep, voffB);
        PG8_WAIT_V(6); PG8_BAR;
    } else {
        PG8_STAGE(PG8_SB(0, 0), cB, voffB); PG8_STAGE(PG8_SA(0, 0), cA, voffA); PG8_STAGE(PG8_SB(0, 1), cB + hstep, voffB); PG8_STAGE(PG8_SA(0, 1), cA + hstep, voffA);
        if (wr == 1) PG8_BAR;
        PG8_WAIT_V(4); PG8_BAR;
        PG8_STAGE(PG8_SB(1, 0), cB + kstep, voffB); PG8_STAGE(PG8_SA(1, 0), cA + kstep, voffA); PG8_STAGE(PG8_SB(1, 1), cB + hstep + kstep, voffB);
        PG8_WAIT_V(6); PG8_BAR;
    }
    for (;;) {
        const bool has_next = S.next(ui + 1, nxt);
        nxt.pa = __builtin_amdgcn_readfirstlane(nxt.pa); nxt.pn = __builtin_amdgcn_readfirstlane(nxt.pn); nxt.bn = __builtin_amdgcn_readfirstlane(nxt.bn); nxt.po = __builtin_amdgcn_readfirstlane(nxt.po); nxt.koff = __builtin_amdgcn_readfirstlane(nxt.koff);
        const PG8_GAS char* nA = has_next ? (const PG8_GAS char*)g.A + (size_t)nxt.pa * tstep + nxt.koff : cA; const PG8_GAS char* nB = has_next ? (const PG8_GAS char*)g.Bt + (size_t)nxt.bn * tstep + nxt.koff : cB;
        for (int kh = 0; kh < (Epi::HAS_MID ? 2 : 1); ++kh) {
        const int t_lo = Epi::HAS_MID ? kh * (nt >> 1) : 0, t_hi = Epi::HAS_MID ? (kh + 1) * (nt >> 1) : nt;
#pragma unroll 1
        for (int t = t_lo; t < t_hi; t += 2) {
            const bool last = (t == nt - 2);
            if (last) E.pre(pf, cur, wr, fr);
            const PG8_GAS char* a1 = cA + (size_t)(t + 1) * kstep;
            const PG8_GAS char* a2 = last ? nA : cA + (size_t)(t + 2) * kstep; const PG8_GAS char* b2 = last ? nB : cB + (size_t)(t + 2) * kstep;
            const PG8_GAS char* a3 = a2 + kstep; const PG8_GAS char* b3 = b2 + kstep;
            if constexpr (SP2) {
            PG8_LDB(B0, 0, 0); PG8_LDB(B1, 0, 1); PG8_SCHED; PG8_LDA(At, 0, 0); PG8_STAGE(PG8_SA(1, 1), a1 + hstep, voffA);
            PG8_WAIT_V(8); PG8_WAIT_L(0); PG8_BAR; PG8_MMA(0, 0, At, B0); PG8_MMA(0, 1, At, B1); PG8_BAR; PG8_SCHED;
            PG8_LDA(At, 0, 1); PG8_STAGE(PG8_SB(0, 0), b2, voffB); PG8_STAGE(PG8_SB(0, 1), b2 + hstep, voffB); PG8_STAGE(PG8_SA(0, 0), a2, voffA);
            PG8_WAIT_V(8); PG8_WAIT_L(0); PG8_BAR; PG8_MMA(1, 0, At, B0); PG8_MMA(1, 1, At, B1); PG8_BAR; PG8_SCHED;
            PG8_LDB(B0, 1, 0); PG8_LDB(B1, 1, 1); PG8_SCHED; PG8_LDA(At, 1, 0); PG8_STAGE(PG8_SA(0, 1), a2 + hstep, voffA);
            PG8_WAIT_V(8); PG8_WAIT_L(0); PG8_BAR; PG8_MMA(0, 0, At, B0); PG8_MMA(0, 1, At, B1); PG8_BAR; PG8_SCHED;
            PG8_LDA(At, 1, 1); PG8_STAGE(PG8_SB(1, 0), b3, voffB); PG8_STAGE(PG8_SB(1, 1), b3 + hstep, voffB); PG8_STAGE(PG8_SA(1, 0), a3, voffA);
            PG8_WAIT_V(8); PG8_WAIT_L(0); PG8_BAR; PG8_MMA(1, 0, At, B0); PG8_MMA(1, 1, At, B1); PG8_BAR; PG8_SCHED;
            } else {
            PG8_LDB(B0, 0, 0); PG8_SCHED; PG8_LDA(At, 0, 0); PG8_STAGE(PG8_SA(1, 1), a1 + hstep, voffA);
            PG8_WAIT_L(8); PG8_BAR; PG8_WAIT_L(0); PG8_MMA(0, 0, At, B0); PG8_BAR; PG8_SCHED;
            PG8_LDB(B1, 0, 1); PG8_STAGE(PG8_SB(0, 0), b2, voffB);
            PG8_BAR; PG8_WAIT_L(0); PG8_MMA(0, 1, At, B1); PG8_BAR;
            PG8_LDA(At, 0, 1); PG8_STAGE(PG8_SA(0, 0), a2, voffA);
            PG8_BAR; PG8_WAIT_L(0); PG8_MMA(1, 0, At, B0); PG8_BAR; PG8_SCHED;
            PG8_STAGE(PG8_SB(0, 1), b2 + hstep, voffB);
            PG8_WAIT_V(6); PG8_BAR; PG8_MMA(1, 1, At, B1); PG8_BAR;
            PG8_LDB(B0, 1, 0); PG8_SCHED; PG8_LDA(At, 1, 0); PG8_STAGE(PG8_SA(0, 1), a2 + hstep, voffA);
            PG8_WAIT_L(8); PG8_BAR; PG8_WAIT_L(0); PG8_MMA(0, 0, At, B0); PG8_BAR; PG8_SCHED;
            PG8_LDB(B1, 1, 1); PG8_STAGE(PG8_SB(1, 0), b3, voffB);
            PG8_BAR; PG8_WAIT_L(0); PG8_MMA(0, 1, At, B1); PG8_BAR;
            PG8_LDA(At, 1, 1); PG8_STAGE(PG8_SA(1, 0), a3, voffA);
            PG8_BAR; PG8_WAIT_L(0); PG8_MMA(1, 0, At, B0); PG8_BAR; PG8_SCHED;
            PG8_STAGE(PG8_SB(1, 1), b3 + hstep, voffB);
            PG8_WAIT_V(6); PG8_BAR; PG8_MMA(1, 1, At, B1); PG8_BAR;
            }
        }
        if (Epi::HAS_MID && kh == 0) E.mid(acc, cur, wr, wc, fr, fq);
        }
        if constexpr (ALIGN_EPI) { if (wr == 0) PG8_BAR; }
        E(acc, cur, wr, wc, fr, fq, pf);
        if (!has_next) break;
        if constexpr (Epi::ACC_INIT) E.init(acc, nxt, wr, wc, fr, fq);
        else {
#pragma unroll
        for (int a = 0; a < 2; ++a)
#pragma unroll
            for (int b = 0; b < 2; ++b)
#pragma unroll
                for (int m = 0; m < 4; ++m)
#pragma unroll
                    for (int n = 0; n < 2; ++n) acc[a][b][m][n] = (f32x4){0.f, 0.f, 0.f, 0.f};
        }
        cur = nxt; cA = nA; cB = nB; ++ui;
        if constexpr (ALIGN_EPI) { if (wr == 1) PG8_BAR; }
    }
    PG8_WAIT_V(0);
    if constexpr (!ALIGN_EPI) { if (wr == 0) PG8_BAR; }
    PG8_BAR;
#undef PG8_SA
#undef PG8_SB
#undef PG8_STAGE
#undef PG8_LDA
#undef PG8_LDB
#undef PG8_MMA
#undef PG8_WAIT_V
#undef PG8_WAIT_L
#undef PG8_BAR
#undef PG8_SCHED
}
}

constexpr int NWAVES = 8;
constexpr int S = 16384, D = 1024, DC = 512, NIN = 4608, FF0 = 2816, FFE = 3584, NE = 8;
constexpr int MAXP = 136;
constexpr float RMS_EPS = 1e-6f, LNC_EPS = 1e-5f;

constexpr size_t MiB = 1u << 20;
constexpr size_t WS_CTL = 0, CTL_ZERO_BYTES = 32 * 1024;
constexpr size_t WS_SS = 1 * MiB;
constexpr size_t WS_TOKE = 2 * MiB, WS_TOKW = WS_TOKE + 64 * 1024, WS_TOKR = WS_TOKW + 128 * 1024, WS_TOKS = WS_TOKR + 64 * 1024, WS_CNT = WS_TOKS + 128 * 1024, WS_PS = WS_CNT + 8 * 1024;
constexpr size_t WS_SLOTR = 3 * MiB, WS_SLOTW = WS_SLOTR + 256 * 1024;
constexpr size_t WS_WM13 = 68 * MiB, WS_WM2 = 124 * MiB;
constexpr size_t WS_WL1 = 152 * MiB, WS_WL0 = 165 * MiB;
constexpr size_t WO_IN = 0, WO_AB = 9 * MiB, WO_O = 11 * MiB, WO_13 = 13 * MiB, WO_2 = 24 * MiB;
constexpr size_t WS_XB = 4 * MiB;
constexpr size_t WS_MG = 36 * MiB;
constexpr size_t WS_POOL = 195 * MiB;
constexpr size_t PO_A = 0, PO_V = 16 * MiB, PO_SB = 32 * MiB, PO_R = 48 * MiB, PO_G = 80 * MiB, PO_A2 = 112 * MiB, PO_HID = 144 * MiB, PO_A1 = 232 * MiB, PO_V1 = 248 * MiB;
constexpr size_t WS_XG = 152 * MiB;
constexpr size_t WS_Y = 186 * MiB;
constexpr size_t WS_HC = 254 * MiB;
constexpr size_t WS_PT = 373 * MiB;
constexpr size_t WS_END = 459 * MiB;
static_assert(WS_XG + (size_t)MAXP * 256 * D <= WS_Y && WS_Y + (size_t)MAXP * 256 * D * 2 <= WS_HC && WS_HC + (size_t)MAXP * 256 * FFE <= WS_END && WS_POOL + PO_HID + (size_t)S * FF0 * 2 <= WS_POOL + PO_A1 && WS_POOL + PO_V1 + 16 * MiB <= WS_END && WS_POOL + PO_A2 + 32 * MiB <= WS_POOL + PO_HID, "d_ws map");
static_assert(WS_XB + (size_t)S * D * 2 <= WS_MG && WS_MG + (size_t)S * D * 2 <= WS_WM13 && WS_WL0 + WO_2 + (size_t)D * FF0 * 2 <= WS_POOL && WS_WM2 + (size_t)NE * D * FFE <= WS_WL1 && WS_WM13 + (size_t)NE * 2 * FFE * D <= WS_WM2 && WS_WL1 + 13 * MiB <= WS_WL0, "weight map");
constexpr int CW_BAR = 4096;
constexpr int CW_XID = 1024;
constexpr int CW_TEAM = 2048;
static_assert((CW_BAR + 3456) * 4 <= (int)CTL_ZERO_BYTES && CW_TEAM + 64 * 16 <= CW_BAR, "barrier words inside the per-call memset");

constexpr int RING_OFF = 0, RING_BYTES = 131072;
constexpr int LDSCTL_OFF = RING_BYTES, MISC_OFF = LDSCTL_OFF + 320;
constexpr int LDS_BYTES = 147456;

#define GAS __attribute__((address_space(1)))
#define LAS __attribute__((address_space(3)))
typedef unsigned short bf16;
typedef unsigned v4u __attribute__((ext_vector_type(4)));
typedef unsigned v2u __attribute__((ext_vector_type(2)));
typedef int v4i __attribute__((ext_vector_type(4)));
typedef int v2i __attribute__((ext_vector_type(2)));
typedef float f32x4 __attribute__((ext_vector_type(4)));
typedef float f32x2 __attribute__((ext_vector_type(2)));
#define LDS_WAIT() asm volatile("s_waitcnt lgkmcnt(0)" ::: "memory")
#define VM_WAIT() asm volatile("s_waitcnt vmcnt(0)" ::: "memory")
using pg8::cvt_pk_bf16; using pg8::bflo; using pg8::bfhi; using pg8::sigmoid_f;

#define XB_TMO      128
#define XB_XCNT(j)  (256  + 64 * (j))
#define XB_XSUB(j)  (1280 + 64 * (j))
#define XB_XGEN(j)  (2304 + 64 * (j))
#define XB_TOP      3328
#define XB_TOPGEN   3392
#define XCD_BAR_WORDS 3456
#define XB_SPIN_CAP (1u << 18)

__device__ __forceinline__ unsigned xb_ld(unsigned* p)              { return __hip_atomic_load(p, __ATOMIC_RELAXED, __HIP_MEMORY_SCOPE_AGENT); }
__device__ __forceinline__ unsigned xb_add(unsigned* p, unsigned v) { return __hip_atomic_fetch_add(p, v, __ATOMIC_RELAXED, __HIP_MEMORY_SCOPE_AGENT); }
__device__ __forceinline__ unsigned xb_xcc_id() { return (unsigned)__builtin_amdgcn_s_getreg((3 << 11) | 20) & 0xFu; }
#define XB_SPIN(cond, bar) do { unsigned _sp = 0; while (cond) { __builtin_amdgcn_s_sleep(1); \
    if ((++_sp & 255u) == 0u) { if (xb_ld(&(bar)[XB_TMO])) break; if (_sp > XB_SPIN_CAP) { atomicAdd(&(bar)[XB_TMO], 1u); break; } } } } while (0)

struct XcdBarrier {
    unsigned* bar; unsigned x;
    volatile LAS unsigned* st;
};
__device__ __forceinline__ XcdBarrier xcd_barrier_post(unsigned* bar, volatile LAS unsigned* st) {
    XcdBarrier b; b.bar = bar; b.x = xb_xcc_id(); b.st = st;
    if (threadIdx.x == 0) (void)xb_add(&bar[XB_XCNT(b.x)], 1u);
    return b;
}
__device__ __forceinline__ void xcd_barrier_complete(unsigned* bar, unsigned x, unsigned& nloc, unsigned& nx) {
    const unsigned G = gridDim.x * gridDim.y * gridDim.z;
    unsigned sum, cnt, mine, sp = 0u;
    for (;;) {
        sum = 0u; cnt = 0u; mine = 0u;
#pragma unroll
        for (unsigned j = 0; j < 16; ++j) { const unsigned c = xb_ld(&bar[XB_XCNT(j)]); sum += c; cnt += (c > 0u) ? 1u : 0u; mine = (j == x) ? c : mine; }
        if (sum == G) break;
        __builtin_amdgcn_s_sleep(1);
        if ((++sp & 255u) == 0u) { if (xb_ld(&bar[XB_TMO])) break; if (sp > XB_SPIN_CAP) { atomicAdd(&bar[XB_TMO], 1u); break; } }
    }
    nloc = mine > 0u ? mine : 1u; nx = cnt > 0u ? cnt : 1u;
}
__device__ __forceinline__ void xcd_barrier(const XcdBarrier& b) {
    asm volatile("s_waitcnt vmcnt(0)" ::: "memory");
    __syncthreads();
    if (threadIdx.x == 0) {
        unsigned* bar = b.bar;
        __builtin_amdgcn_s_waitcnt(0);
        unsigned nloc = b.st[0], nx = b.st[1];
        if (nloc == 0u) { xcd_barrier_complete(bar, b.x, nloc, nx); b.st[0] = nloc; b.st[1] = nx; }
        const unsigned old = xb_add(&bar[XB_XSUB(b.x)], 1u);
        const unsigned gen = old / nloc;
        if (old + 1u == (gen + 1u) * nloc) {
            __builtin_amdgcn_fence(__ATOMIC_RELEASE, "agent");
            asm volatile("s_waitcnt vmcnt(0)" ::: "memory");
            const unsigned og = xb_add(&bar[XB_TOP], 1u);
            const unsigned tg = og / nx;
            if (og + 1u == (tg + 1u) * nx) xb_add(&bar[XB_TOPGEN], 1u);
            else XB_SPIN(xb_ld(&bar[XB_TOPGEN]) == tg, bar);
            __builtin_amdgcn_fence(__ATOMIC_ACQUIRE, "agent");
            xb_add(&bar[XB_XGEN(b.x)], 1u);
            asm volatile("s_waitcnt vmcnt(0)" ::: "memory");
        } else {
            XB_SPIN(xb_ld(&bar[XB_XGEN(b.x)]) == gen, bar);
            __builtin_amdgcn_fence(__ATOMIC_ACQUIRE, "agent");
            asm volatile("s_waitcnt vmcnt(0)" ::: "memory");
        }
    }
    __syncthreads();
}

__device__ __forceinline__ void team_barrier(unsigned* cnt, unsigned target, bool coloc, unsigned* tmo_bar) {
    asm volatile("s_waitcnt vmcnt(0)" ::: "memory");
    __syncthreads();
    if (threadIdx.x == 0) {
        __builtin_amdgcn_s_waitcnt(0);
        if (!coloc) { __builtin_amdgcn_fence(__ATOMIC_RELEASE, "agent"); asm volatile("s_waitcnt vmcnt(0)" ::: "memory"); }
        (void)xb_add(cnt, 1u);
        XB_SPIN(xb_ld(cnt) < target, tmo_bar);
        __builtin_amdgcn_fence(__ATOMIC_ACQUIRE, "agent");
        asm volatile("s_waitcnt vmcnt(0)" ::: "memory");
    }
    __syncthreads();
}

__device__ __forceinline__ float wave_sum(float v) {
#pragma unroll
    for (int o = 1; o < 64; o <<= 1) v += __shfl_xor(v, o);
    return v;
}
template <bool F8> __device__ __forceinline__ void tr_load(const float* src, int spitch, int scol0, const float* scale, float sc0, int k0, int lane, unsigned (&pa)[F8 ? 16 : 32], unsigned (&pb)[F8 ? 16 : 32]) {
    const int h = lane >> 5, c = lane & 31;
    const float* s = src + (size_t)(k0 + h) * spitch + scol0 + 4 * c;
    f32x4 x[32];
#pragma unroll
    for (int i = 0; i < 32; ++i) x[i] = __builtin_nontemporal_load((const f32x4*)(s + (size_t)(2 * i) * spitch));
#pragma unroll
    for (int i = 0; i < 32; i += 2) {
        float ea[2], oa[2], eb[2], ob[2];
#pragma unroll
        for (int d = 0; d < 2; ++d) {
            const float sk = scale ? scale[k0 + 2 * (i + d) + h] * sc0 : sc0;
            const f32x4 y = x[i + d] * sk;
            auto r = __builtin_amdgcn_permlane32_swap(__float_as_uint(y.x), __float_as_uint(y.z), false, false); ea[d] = __uint_as_float(r[0]); oa[d] = __uint_as_float(r[1]);
            auto q = __builtin_amdgcn_permlane32_swap(__float_as_uint(y.y), __float_as_uint(y.w), false, false); eb[d] = __uint_as_float(q[0]); ob[d] = __uint_as_float(q[1]);
        }
        if (F8) { pa[i >> 1] = pg8::pk4_fp8(ea[0], oa[0], ea[1], oa[1]); pb[i >> 1] = pg8::pk4_fp8(eb[0], ob[0], eb[1], ob[1]); }
        else { pa[i] = cvt_pk_bf16(ea[0], oa[0]); pa[i + 1] = cvt_pk_bf16(ea[1], oa[1]); pb[i] = cvt_pk_bf16(eb[0], ob[0]); pb[i + 1] = cvt_pk_bf16(eb[1], ob[1]); }
    }
}
__device__ __forceinline__ void tr_item(const float* src, int spitch, int scol0, const float* scale, bf16* dst, int dpitch, int drow0, int dk0, int k0, int lane, LAS unsigned char* tile) {
    unsigned pa[32], pb[32];
    tr_load<false>(src, spitch, scol0, scale, 1.0f, k0, lane, pa, pb);
    const int ra = 4 * (lane & 31) + 2 * (lane >> 5), sa = (ra >> 1) & 7;
#pragma unroll
    for (int j = 0; j < 8; ++j) {
        *(LAS v4u*)(tile + ra * 128 + ((j ^ sa) << 4)) = (v4u){pa[4 * j], pa[4 * j + 1], pa[4 * j + 2], pa[4 * j + 3]};
        *(LAS v4u*)(tile + (ra + 1) * 128 + ((j ^ sa) << 4)) = (v4u){pb[4 * j], pb[4 * j + 1], pb[4 * j + 2], pb[4 * j + 3]};
    }
#pragma unroll
    for (int jj = 0; jj < 16; ++jj) { const int r = (lane >> 3) + 8 * jj, pc = lane & 7, ch = pc ^ ((r >> 1) & 7);
        const v4u v = *(const LAS v4u*)(tile + r * 128 + (pc << 4));
        *(v4u*)(dst + (size_t)(drow0 + r) * dpitch + dk0 + k0 + 8 * ch) = v; }
}
template <int HALF> __device__ __forceinline__ void tr_item_f8(const float* src, int spitch, int scol0, const float* scale, unsigned char* dst, int dpitch, int drow0, int k0, int lane, LAS unsigned char* tile) {
    const int ra = 4 * (lane & 31) + 2 * (lane >> 5), sa = (ra >> 1) & 7;
#pragma unroll 1
    for (int hf = (HALF < 0 ? 0 : HALF); hf < (HALF < 0 ? 2 : HALF + 1); ++hf) {
        unsigned pa[16], pb[16];
        tr_load<true>(src, spitch, scol0, scale, pg8::F8_WSCALE, k0 + 64 * hf, lane, pa, pb);
#pragma unroll
        for (int j = 0; j < 4; ++j) {
            *(LAS v4u*)(tile + ra * 128 + (((4 * hf + j) ^ sa) << 4)) = (v4u){pa[4 * j], pa[4 * j + 1], pa[4 * j + 2], pa[4 * j + 3]};
            *(LAS v4u*)(tile + (ra + 1) * 128 + (((4 * hf + j) ^ sa) << 4)) = (v4u){pb[4 * j], pb[4 * j + 1], pb[4 * j + 2], pb[4 * j + 3]};
        }
    }
    if (HALF < 0) {
#pragma unroll
        for (int jj = 0; jj < 16; ++jj) { const int r = (lane >> 3) + 8 * jj, pc = lane & 7, ch = pc ^ ((r >> 1) & 7);
            const v4u v = *(const LAS v4u*)(tile + r * 128 + (pc << 4));
            *(v4u*)(dst + (size_t)(drow0 + r) * dpitch + k0 + 16 * ch) = v; }
    } else {
#pragma unroll
        for (int jj = 0; jj < 8; ++jj) { const int r = (lane >> 2) + 16 * jj, ch = 4 * HALF + (lane & 3), pc = ch ^ ((r >> 1) & 7);
            const v4u v = *(const LAS v4u*)(tile + r * 128 + (pc << 4));
            *(v4u*)(dst + (size_t)(drow0 + r) * dpitch + k0 + 16 * ch) = v; }
    }
}

struct Args { const float* in[31]; float* out; unsigned char* ws; int ph_lo, ph_hi; };

constexpr int I_IN = 36 * 16, I_A = 8 * 8, I_O = 8 * 16, I_MIX = I_IN + 2 * I_A + I_O, I_13 = 44 * 16, I_2 = 8 * 44, I_M13 = 56 * 8, I_M2 = 8 * 28;
__device__ __forceinline__ void wt_item(const Args& a, int it, int lane, LAS unsigned char* tile) {
    unsigned char* ws = a.ws;
    int r = it;
    if (r < 2 * I_MIX) {
        const int L = r / I_MIX; r -= L * I_MIX;
        unsigned char* wl = ws + (L ? WS_WL1 : WS_WL0);
        if (r < I_IN) {
            const int kb = r / 36, nb = r % 36, u = nb >> 1, bj = nb & 1;
            int col0;
            if (u < 4) col0 = (bj ? 512 : 0) + 128 * u;
            else if (u < 8) col0 = (bj ? 2048 : 1536) + 128 * (u - 4);
            else if (u < 10) col0 = 1024 + 256 * (u - 8) + 128 * bj;
            else col0 = (bj ? 3584 : 2560) + 128 * (u - 10);
            tr_item(L ? a.in[16] : a.in[2], NIN, col0, L ? a.in[15] : a.in[1], (bf16*)(wl + WO_IN), D, nb * 128, 0, kb * 64, lane, tile);
        } else if (r < I_IN + I_A) { r -= I_IN; const int kb = r / 8, nb = r % 8;
            tr_item(L ? a.in[21] : a.in[7], D, nb * 128, nullptr, (bf16*)(wl + WO_AB), D, nb * 128, 0, kb * 64, lane, tile);
        } else if (r < I_IN + 2 * I_A) { r -= I_IN + I_A; const int kb = r / 8, nb = r % 8;
            tr_item(L ? a.in[23] : a.in[9], D, nb * 128, nullptr, (bf16*)(wl + WO_AB), D, nb * 128, DC, kb * 64, lane, tile);
        } else { r -= I_IN + 2 * I_A; const int kb = r / 8, nb = r % 8;
            tr_item(L ? a.in[24] : a.in[10], D, nb * 128, nullptr, (bf16*)(wl + WO_O), D, nb * 128, 0, kb * 64, lane, tile);
        }
        return;
    }
    r -= 2 * I_MIX;
    if (r < I_13) {
        const int kb = r / 44, nb = r % 44, u = nb >> 1, bj = nb & 1;
        tr_item(bj ? a.in[13] : a.in[12], FF0, 128 * u, a.in[11], (bf16*)(ws + WS_WL0 + WO_13), D, nb * 128, 0, kb * 64, lane, tile);
        return;
    }
    r -= I_13;
    if (r < I_2) { const int kb = r / 8, nb = r % 8;
        tr_item(a.in[14], D, nb * 128, nullptr, (bf16*)(ws + WS_WL0 + WO_2), FF0, nb * 128, 0, kb * 64, lane, tile);
        return;
    }
}
constexpr int N_MOE_ITEMS = NE * (I_M13 + I_M2), N_DENSE_ITEMS = 2 * I_MIX + I_13 + I_2;
constexpr int SLOT_Q = 2, SLOT_EXTRA_WGS = 0, N_SLOT_ITEMS = 512 * SLOT_Q + SLOT_EXTRA_WGS * 4;
constexpr int N_MOE_P0 = N_MOE_ITEMS - 3 * N_SLOT_ITEMS;
template <int HALF> __device__ __forceinline__ void moe_item(const Args& a, int r, int lane, LAS unsigned char* tile) {
    unsigned char* ws = a.ws;
    if (r < NE * I_M13) {
        const int e = r / I_M13; r -= e * I_M13;
        const int kb = r / 56, nb = r % 56, u = nb >> 1, bj = nb & 1;
        tr_item_f8<HALF>((bj ? a.in[28] : a.in[27]) + (size_t)e * D * FFE, FFE, 128 * u, a.in[25], ws + WS_WM13 + (size_t)e * 2 * FFE * D, D, nb * 128, kb * 128, lane, tile);
        return;
    }
    r -= NE * I_M13;
    { const int e = r / I_M2; r -= e * I_M2; const int kb = r / 8, nb = r % 8;
      tr_item_f8<HALF>(a.in[29] + (size_t)e * FFE * D, D, nb * 128, nullptr, ws + WS_WM2 + (size_t)e * D * FFE, FFE, nb * 128, kb * 128, lane, tile); }
}
#define MOE_SLOT(s) do { if (G == 256 && bid >= 128) { \
        for (int q_ = 0; q_ < SLOT_Q + ((bid >= 256 - SLOT_EXTRA_WGS) ? 1 : 0); ++q_) { \
            const int it_ = N_MOE_P0 + (s) * N_SLOT_ITEMS + (q_ < SLOT_Q ? q_ * 512 + (bid - 128) * (NWAVES / 2) : SLOT_Q * 512 + (bid - (256 - SLOT_EXTRA_WGS)) * (NWAVES / 2)) + (wave >> 1); \
            if (wave & 1) moe_item<1>(args, it_, lane, lds + RING_OFF + wave * 16384); else moe_item<0>(args, it_, lane, lds + RING_OFF + wave * 16384); } } } while (0)

__global__ void __launch_bounds__(NWAVES * 64, 2) fwd(Args args) {
    extern __shared__ __attribute__((aligned(16))) unsigned char lds_raw[];
    LAS unsigned char* lds = (LAS unsigned char*)lds_raw;
    volatile LAS unsigned* MISC = (volatile LAS unsigned*)(lds + MISC_OFF);
    const int tid = threadIdx.x, lane = tid & 63, wave = __builtin_amdgcn_readfirstlane(tid >> 6);
    const int G = gridDim.x; const int vcu = (G % 8 == 0) ? ((int)blockIdx.x % 8) * (G / 8) + (int)blockIdx.x / 8 : (int)blockIdx.x;
    unsigned char* const ws = args.ws;
    unsigned* const ctl = (unsigned*)(ws + WS_CTL);
    for (int u = tid; u < (LDS_BYTES - LDSCTL_OFF) / 4; u += NWAVES * 64) ((LAS unsigned*)(lds + LDSCTL_OFF))[u] = 0u;
    __syncthreads();
    XcdBarrier bar; bar.bar = ctl + CW_BAR; bar.x = 0; bar.st = nullptr;
    if (!MK_PER_PHASE) bar = xcd_barrier_post(ctl + CW_BAR, MISC + 8);
    if (!MK_PER_PHASE && threadIdx.x == 0) __hip_atomic_store(ctl + CW_XID + blockIdx.x, bar.x + 1u, __ATOMIC_RELAXED, __HIP_MEMORY_SCOPE_AGENT);
    const int lo = args.ph_lo, hi = args.ph_hi;
#ifndef PH_MASK
#define PH_MASK 0xFFFFu
#endif
#define IN(k) (((PH_MASK >> (k)) & 1u) && lo <= (k) && (k) < hi)
#ifndef REP_MASK
#define REP_MASK 0u
#endif
#define REPS(k) (1 + (int)((REP_MASK >> (k)) & 1u))
#define SEAM(k) do { if (IN((k) + 1)) { if (MK_PER_PHASE) { if (tid == 0) __hip_atomic_store(ctl + 0, 0xBADBA0u, __ATOMIC_RELAXED, __HIP_MEMORY_SCOPE_AGENT); } else xcd_barrier(bar); } } while (0)
#define TEAM_CHECK() do { if (!MK_PER_PHASE && threadIdx.x == 0) { unsigned ok_ = 1u; for (int j_ = 0; j_ < 4; ++j_) ok_ &= (xb_ld(ctl + CW_XID + ((int)blockIdx.x & 63) + 64 * j_) == bar.x + 1u) ? 1u : 0u; MISC[12] = ok_; } } while (0)
#define TEAM_SEAM(k, seq) do { if (IN((k) + 1)) { if (!MK_PER_PHASE && G == 256) team_barrier(ctl + CW_TEAM + 16 * (8 * ((int)blockIdx.x & 7) + (((int)blockIdx.x >> 3) & 7)), 4u * ((unsigned)(seq) + 1u), MISC[12] != 0u, ctl + CW_BAR); else SEAM(k); } } while (0)
    const int gw = vcu * NWAVES + wave, NGW = G * NWAVES;
    const int vr = (G == 256) ? 4 * (8 * ((int)blockIdx.x & 7) + (((int)blockIdx.x >> 3) & 7)) + ((int)blockIdx.x >> 6) : vcu;
#define PHASE_PTRS() GAS unsigned char* wsp = (GAS unsigned char*)ws; asm volatile("" : "+s"(wsp)); int bid = (int)blockIdx.x; asm volatile("" : "+s"(bid)); (void)bid; int tidp_ = (int)threadIdx.x; asm volatile("" : "+v"(tidp_)); const int tid = tidp_, lane = tid & 63; (void)tid; (void)lane; float* const ssb = (float*)(wsp + WS_SS); bf16* const XB = (bf16*)(wsp + WS_XB); \
    GAS unsigned char* const pool = wsp + WS_POOL; (void)ssb; (void)XB; (void)pool

#define RSTD_TABLE(pa) do { LAS float* rt_ = (LAS float*)(lds + LDSCTL_OFF + 1024); if (tid < 256) { const f32x4* p_ = (const f32x4*)(ssb + ((size_t)(pa) * 256 + tid) * 16); \
        const f32x4 a_ = p_[0], b_ = p_[1], c_ = p_[2], d_ = p_[3]; const float s_ = (((a_.x + a_.y) + (a_.z + a_.w)) + ((b_.x + b_.y) + (b_.z + b_.w))) + (((c_.x + c_.y) + (c_.z + c_.w)) + ((d_.x + d_.y) + (d_.z + d_.w))); \
        rt_[tid] = __builtin_amdgcn_rsqf(s_ * (1.0f / 1024.0f) + 1e-6f); } __syncthreads(); } while (0)
    const LAS float* const RTAB = (const LAS float*)(lds + LDSCTL_OFF + 1024);

    if (IN(0)) {
        PHASE_PTRS();
        for (int rep_ = 0; rep_ < REPS(0); ++rep_)
        if (G == 256 && N_MOE_P0 >= 2048 && N_MOE_P0 <= 2304) {
            LAS unsigned char* const til = lds + RING_OFF + wave * 16384;
#pragma unroll 1
            for (int st = 0; st < 3; ++st) {
                int kind = 0, idx = 0;
                if (st == 0) { kind = 1; idx = wave * 256 + bid; }
                else if (wave == 0) { kind = (st == 1 && 2048 + bid < N_MOE_P0) ? 1 : 0; idx = 2048 + bid; }
                else { const int d = (wave - 1) * 256 + bid; if (st == 1) { kind = 2; idx = d; } else { kind = (1792 + d < N_DENSE_ITEMS) ? 2 : 0; idx = 1792 + d; } }
                if (kind == 1) moe_item<-1>(args, idx, lane, til); else if (kind == 2) wt_item(args, idx, lane, til);
            }
        } else
        for (int it = gw; it < N_DENSE_ITEMS + N_MOE_P0; it += NGW) { if (it < N_DENSE_ITEMS) wt_item(args, it, lane, lds + RING_OFF + wave * 16384); else moe_item<-1>(args, it - N_DENSE_ITEMS, lane, lds + RING_OFF + wave * 16384); }
        const float* x = args.in[0];
        for (int m0 = gw; m0 < S; m0 += 4 * NGW) {
            f32x4 v[4][4];
#pragma unroll
            for (int b = 0; b < 4; ++b) { const f32x4* xr = (const f32x4*)(x + (size_t)(m0 + b * NGW) * D) + lane;
#pragma unroll
                for (int j = 0; j < 4; ++j) v[b][j] = __builtin_nontemporal_load(xr + 64 * j); }
#pragma unroll
            for (int b = 0; b < 4; ++b) {
                const int m = m0 + b * NGW; float s = 0.f;
#pragma unroll
                for (int j = 0; j < 4; ++j) s += (v[b][j].x * v[b][j].x + v[b][j].y * v[b][j].y) + (v[b][j].z * v[b][j].z + v[b][j].w * v[b][j].w);
                s = wave_sum(s);
                v2u* o8 = (v2u*)(XB + (size_t)m * D) + lane;
#pragma unroll
                for (int j = 0; j < 4; ++j) { v2u w; w.x = cvt_pk_bf16(v[b][j].x, v[b][j].y); w.y = cvt_pk_bf16(v[b][j].z, v[b][j].w); o8[64 * j] = w; }
                if (lane < 16) ssb[(size_t)m * 16 + lane] = (lane == 0) ? s : 0.f;
            }
        }
        SEAM(0);
    }

    for (int layer = 0; layer < 2; ++layer) {
        const int pb = 1 + 6 * layer;
        if (IN(pb)) {
            PHASE_PTRS(); GAS unsigned char* const wl = wsp + (layer ? WS_WL1 : WS_WL0); (void)wl;
            pg8::Gemm g{XB, (const bf16*)(wl + WO_IN), D, D};
            int pa0; { pg8::StaticOrder S0; S0.init(S / 256, 10, G, bid, 0); pg8::Unit u0; pa0 = S0.next(0, u0) ? u0.pa : 0; }
            if (layer == 0) TEAM_CHECK();
            RSTD_TABLE(pa0);
            for (int rep_ = 0; rep_ < REPS(1); ++rep_)
            { pg8::StaticOrder So; So.init(S / 256, 10, G, bid, 0);
              pg8::EpiG1<0> E{ssb, (bf16*)(pool + (layer ? PO_A1 : PO_A)), (bf16*)(pool + (layer ? PO_V1 : PO_V)), (bf16*)(pool + PO_SB), (bf16*)(pool + PO_R), (bf16*)(pool + PO_G), RTAB, pa0};
              pg8::gemm_phase<pg8::EpiG1<0>, pg8::StaticOrder, true, true>(lds + RING_OFF, g, So, E); }
            for (int rep_ = 0; rep_ < REPS(20); ++rep_)
            { pg8::StaticOrder So; So.init(S / 256, 8, G, bid, 10);
              pg8::EpiG1<1> E{ssb, (bf16*)(pool + (layer ? PO_A1 : PO_A)), (bf16*)(pool + (layer ? PO_V1 : PO_V)), (bf16*)(pool + PO_SB), (bf16*)(pool + PO_R), (bf16*)(pool + PO_G), RTAB, pa0};
              pg8::gemm_phase<pg8::EpiG1<1>, pg8::StaticOrder, true, true>(lds + RING_OFF, g, So, E); }
            if (layer == 0) MOE_SLOT(0); else MOE_SLOT(2);
            SEAM(pb);
        }
        if (IN(pb + 1)) {
            PHASE_PTRS(); GAS unsigned char* const wl = wsp + (layer ? WS_WL1 : WS_WL0); (void)wl;
            const float* conv_a = layer ? args.in[17] : args.in[3]; const float* conv_ab = layer ? args.in[18] : args.in[4];
            const float* ln_g = layer ? args.in[19] : args.in[5]; const float* ln_b = layer ? args.in[20] : args.in[6]; const float* conv_b = layer ? args.in[22] : args.in[8];
            const bf16* abuf = (const bf16*)(pool + (layer ? PO_A1 : PO_A)); const bf16* vbuf = (const bf16*)(pool + (layer ? PO_V1 : PO_V)); const bf16* sbuf = (const bf16*)(pool + PO_SB); bf16* A2 = (bf16*)(pool + PO_A2);
            LAS float* cv = (LAS float*)(lds + RING_OFF);
            LAS float* wl31 = (LAS float*)(lds + RING_OFF + 65536);
            const int cq = tid & 127, oct = tid >> 7;
            for (int idx = tid; idx < 31 * DC / 4; idx += NWAVES * 64) ((LAS f32x4*)wl31)[idx] = ((const f32x4*)conv_a)[idx];
            f32x4 wb[3];
#pragma unroll
            for (int j = 0; j < 3; ++j) wb[j] = *(const f32x4*)(conv_b + j * DC + 4 * cq);
            const f32x4 cbias = *(const f32x4*)(conv_ab + 4 * cq);
            const f32x4 g0 = *(const f32x4*)(ln_g + 4 * lane), g1 = *(const f32x4*)(ln_g + 256 + 4 * lane), b0 = *(const f32x4*)(ln_b + 4 * lane), b1 = *(const f32x4*)(ln_b + 256 + 4 * lane);
            __syncthreads();
            int ctile0 = vcu, cstep = G;
            if (G == 256) { ctile0 = 8 * (8 * (bid & 7) + ((bid >> 3) & 7)) + 2 * (bid >> 6); cstep = 1; }
            for (int rep_ = 0; rep_ < REPS(2); ++rep_)
            for (int tile = ctile0, tcount = 0; (G == 256) ? (tcount < 2) : (tile < S / 32); tile += cstep, ++tcount) {
                const int tb = tile * 32 + oct * 8;
                {
                    v2u in[38];
#pragma unroll
                    for (int i = 0; i < 38; ++i) { const int r = tb - 30 + i; in[i] = (r >= 0) ? *(const v2u*)(abuf + (size_t)r * DC + 4 * cq) : (v2u){0u, 0u}; }
                    v2u vin[10], sv[8];
#pragma unroll
                    for (int i = 0; i < 10; ++i) { const int r = tb - 2 + i; vin[i] = (r >= 0) ? *(const v2u*)(vbuf + (size_t)r * DC + 4 * cq) : (v2u){0u, 0u}; }
#pragma unroll
                    for (int o = 0; o < 8; ++o) sv[o] = *(const v2u*)(sbuf + (size_t)(tb + o) * DC + 4 * cq);
                    f32x4 acc8[8];
#pragma unroll
                    for (int o = 0; o < 8; ++o) acc8[o] = cbias;
#pragma unroll
                    for (int j = 0; j < 31; ++j) { const f32x4 w = *(const LAS f32x4*)(wl31 + j * DC + 4 * cq);
#pragma unroll
                        for (int o = 0; o < 8; ++o) { const v2u x = in[o + j]; acc8[o] += (f32x4){bflo(x.x), bfhi(x.x), bflo(x.y), bfhi(x.y)} * w; } }
#pragma unroll
                    for (int o = 0; o < 8; ++o) *(LAS f32x4*)(cv + (oct * 8 + o) * DC + 4 * cq) = acc8[o];
#pragma unroll
                    for (int o = 0; o < 8; ++o) {
                        f32x4 u = (f32x4){0.f, 0.f, 0.f, 0.f};
#pragma unroll
                        for (int j = 0; j < 3; ++j) { const v2u x = vin[o + j]; u += (f32x4){bflo(x.x), bfhi(x.x), bflo(x.y), bfhi(x.y)} * wb[j]; }
                        const v2u s = sv[o]; v2u w; w.x = cvt_pk_bf16(bflo(s.x) * u.x, bfhi(s.x) * u.y); w.y = cvt_pk_bf16(bflo(s.y) * u.z, bfhi(s.y) * u.w);
                        *(v2u*)(A2 + (size_t)(tb + o) * D + DC + 4 * cq) = w;
                    }
                }
                __syncthreads();
#pragma unroll
                for (int tk = 0; tk < 4; ++tk) {
                    const int t = wave * 4 + tk;
                    const f32x4 xa = *(const LAS f32x4*)(cv + t * DC + 4 * lane), xc = *(const LAS f32x4*)(cv + t * DC + 256 + 4 * lane);
                    const float mean = wave_sum((xa.x + xa.y) + (xa.z + xa.w) + (xc.x + xc.y) + (xc.z + xc.w)) * (1.f / DC);
                    const f32x4 da = xa - mean, dc = xc - mean;
                    const float var = wave_sum((da.x * da.x + da.y * da.y) + (da.z * da.z + da.w * da.w) + (dc.x * dc.x + dc.y * dc.y) + (dc.z * dc.z + dc.w * dc.w)) * (1.f / DC);
                    const float rstd = __builtin_amdgcn_rsqf(var + LNC_EPS);
                    f32x4 ya = da * rstd * g0 + b0, yc = dc * rstd * g1 + b1;
#pragma unroll
                    for (int j = 0; j < 4; ++j) { ya[j] = ya[j] * sigmoid_f(ya[j]); yc[j] = yc[j] * sigmoid_f(yc[j]); }
                    bf16* orow = A2 + (size_t)(tile * 32 + t) * D;
                    v2u w; w.x = cvt_pk_bf16(ya.x, ya.y); w.y = cvt_pk_bf16(ya.z, ya.w); *(v2u*)(orow + 4 * lane) = w;
                    w.x = cvt_pk_bf16(yc.x, yc.y); w.y = cvt_pk_bf16(yc.z, yc.w); *(v2u*)(orow + 256 + 4 * lane) = w;
                }
                __syncthreads();
            }
            TEAM_SEAM(pb + 1, layer ? 5 : 0);
        }
        if (IN(pb + 2)) {
            PHASE_PTRS(); GAS unsigned char* const wl = wsp + (layer ? WS_WL1 : WS_WL0); (void)wl;
            pg8::StaticOrder So; So.init(S / 256, D / 256, G, bid);
            pg8::Gemm g{(const bf16*)(pool + PO_A2), (const bf16*)(wl + WO_AB), D, D};
            pg8::EpiG2 E{(const bf16*)(pool + PO_R), (const bf16*)(pool + PO_G), (bf16*)(wsp + WS_MG)};
            for (int rep_ = 0; rep_ < REPS(3); ++rep_)
            pg8::gemm_phase<pg8::EpiG2, pg8::StaticOrder, true, true>(lds + RING_OFF, g, So, E);
            TEAM_SEAM(pb + 2, layer ? 6 : 1);
        }
        if (IN(pb + 3)) {
            PHASE_PTRS(); GAS unsigned char* const wl = wsp + (layer ? WS_WL1 : WS_WL0); (void)wl;
            pg8::Gemm g{(const bf16*)(wsp + WS_MG), (const bf16*)(wl + WO_O), D, D}; pg8::StaticOrder So; So.init(S / 256, D / 256, G, bid);
            if (layer == 0) { pg8::EpiRes<true, true> E{args.in[0], XB, ssb};
                pg8::gemm_phase<pg8::EpiRes<true, true>, pg8::StaticOrder, true, true>(lds + RING_OFF, g, So, E); }
            else { pg8::EpiRes<false, false> E{nullptr, XB, ssb};
                pg8::gemm_phase<pg8::EpiRes<false, false>, pg8::StaticOrder, true, true>(lds + RING_OFF, g, So, E); }
            TEAM_SEAM(pb + 3, layer ? 7 : 2);
        }
        if (layer == 0) {
            if (IN(5)) {
                PHASE_PTRS();
                pg8::Gemm g{XB, (const bf16*)(wsp + WS_WL0 + WO_13), D, D}; pg8::StaticOrder So; So.init(S / 256, 2 * FF0 / 256, G, bid);
                int pa0; { pg8::Unit u0; pa0 = So.next(0, u0) ? u0.pa : 0; }
                RSTD_TABLE(pa0);
                pg8::EpiUp<false> E{ssb, (bf16*)(pool + PO_HID), FF0, RTAB, pa0};
                for (int rep_ = 0; rep_ < REPS(5); ++rep_)
                pg8::gemm_phase<pg8::EpiUp<false>, pg8::StaticOrder, true, true>(lds + RING_OFF, g, So, E);
                MOE_SLOT(1);
                TEAM_SEAM(5, 3);
            }
            if (IN(6)) {
                PHASE_PTRS();
                pg8::Gemm g{(const bf16*)(pool + PO_HID), (const bf16*)(wsp + WS_WL0 + WO_2), FF0, FF0}; pg8::StaticOrder So; So.init(S / 256, D / 256, G, bid);
                pg8::EpiRes<true, false> E{nullptr, XB, ssb};
                pg8::gemm_phase<pg8::EpiRes<true, false>, pg8::StaticOrder, true, true>(lds + RING_OFF, g, So, E);
                TEAM_SEAM(6, 4);
            }
        }
    }

#define MOE_PTRS() PHASE_PTRS(); unsigned* const tok_e = (unsigned*)(wsp + WS_TOKE); f32x2* const tok_w = (f32x2*)(wsp + WS_TOKW); float* const tok_r = (float*)(wsp + WS_TOKR); v2i* const tok_s = (v2i*)(wsp + WS_TOKS); \
    int* const cntg = (int*)(wsp + WS_CNT); int* const psg = (int*)(wsp + WS_PS); float* const slot_r = (float*)(wsp + WS_SLOTR); float* const slot_w = (float*)(wsp + WS_SLOTW); \
    unsigned char* const XG = (unsigned char*)(wsp + WS_XG); unsigned char* const HC = (unsigned char*)(wsp + WS_HC); unsigned char* const Y = (unsigned char*)(wsp + WS_Y); (void)Y; unsigned char* const PT = (unsigned char*)(wsp + WS_PT); (void)PT; (void)tok_e; (void)tok_w; (void)tok_r; (void)tok_s; (void)cntg; (void)psg; (void)slot_r; (void)slot_w; (void)XG; (void)HC

    if (IN(11)) {
        MOE_PTRS();
        LAS float* rgA = (LAS float*)(lds + RING_OFF);
        LAS float* rgB = rgA + 4096;
        LAS int* hist = (LAS int*)(lds + RING_OFF + 32768);
        const float* router = args.in[26]; const float* g2 = args.in[25];
        for (int idx = tid; idx < 8192; idx += NWAVES * 64) { const int k = idx >> 3, e = idx & 7, j = k >> 8, ln = (k & 255) >> 2, i = k & 3;
            (e < 4 ? rgA : rgB)[((j * 4 + i) * 64 + ln) * 4 + (e & 3)] = router[idx] * g2[k]; }
        if (tid < 8) hist[tid] = 0;
        __syncthreads();
        for (int tb4 = 0; tb4 < 8; tb4 += 4) {
        v2u xrow[4][4];
#pragma unroll
        for (int b = 0; b < 4; ++b) { const v2u* xr_ = (const v2u*)(XB + (size_t)(vr * 64 + wave * 8 + tb4 + b) * D) + lane;
#pragma unroll
            for (int j = 0; j < 4; ++j) xrow[b][j] = xr_[64 * j]; }
#pragma unroll
        for (int b = 0; b < 4; ++b) {
            const int t = vr * 64 + wave * 8 + tb4 + b;
            float ac[8]; float sq = 0.f;
#pragma unroll
            for (int e = 0; e < 8; ++e) ac[e] = 0.f;
#pragma unroll
            for (int j = 0; j < 4; ++j) { const v2u xp = xrow[b][j]; const f32x4 xv = (f32x4){bflo(xp.x), bfhi(xp.x), bflo(xp.y), bfhi(xp.y)};
#pragma unroll
                for (int i = 0; i < 4; ++i) { const float xx = xv[i]; sq += xx * xx;
                    const f32x4 ra = *(const LAS f32x4*)(rgA + ((j * 4 + i) * 64 + lane) * 4), rb = *(const LAS f32x4*)(rgB + ((j * 4 + i) * 64 + lane) * 4);
                    ac[0] += xx * ra.x; ac[1] += xx * ra.y; ac[2] += xx * ra.z; ac[3] += xx * ra.w; ac[4] += xx * rb.x; ac[5] += xx * rb.y; ac[6] += xx * rb.z; ac[7] += xx * rb.w; } }
            sq = wave_sum(sq);
#pragma unroll
            for (int e = 0; e < 8; ++e) ac[e] = wave_sum(ac[e]);
            const float rstd = __builtin_amdgcn_rsqf(sq * (1.f / D) + RMS_EPS);
            int e0 = 0; float l0 = ac[0];
#pragma unroll
            for (int e = 1; e < 8; ++e) if (ac[e] > l0) { l0 = ac[e]; e0 = e; }
            int e1 = -1; float l1 = 0.f;
#pragma unroll
            for (int e = 0; e < 8; ++e) if (e != e0 && (e1 < 0 || ac[e] > l1)) { l1 = ac[e]; e1 = e; }
            const float w0 = 1.0f / (1.0f + __expf((l1 - l0) * rstd)), w1 = 1.0f - w0;
            if (lane == 0) { tok_e[t] = (unsigned)e0 | ((unsigned)e1 << 8); tok_w[t] = (f32x2){w0, w1}; tok_r[t] = rstd; __hip_atomic_fetch_add(&hist[e0], 1, __ATOMIC_RELAXED, __HIP_MEMORY_SCOPE_WORKGROUP); __hip_atomic_fetch_add(&hist[e1], 1, __ATOMIC_RELAXED, __HIP_MEMORY_SCOPE_WORKGROUP); }
        }
        }
        __syncthreads();
        if (tid < 8) cntg[vr * 8 + tid] = hist[tid];
        __syncthreads();
        SEAM(11);
    }
    if (IN(12)) {
        MOE_PTRS();
        LAS int* sh = (LAS int*)(lds + RING_OFF);
        if (tid < 16) sh[tid] = 0;
        __syncthreads();
        if (tid < G) { const v4i c0 = *(const v4i*)(cntg + tid * 8), c1 = *(const v4i*)(cntg + tid * 8 + 4); const int c[8] = {c0.x, c0.y, c0.z, c0.w, c1.x, c1.y, c1.z, c1.w};
#pragma unroll
            for (int e = 0; e < 8; ++e) { __hip_atomic_fetch_add(&sh[e], c[e], __ATOMIC_RELAXED, __HIP_MEMORY_SCOPE_WORKGROUP); if (tid < vr) __hip_atomic_fetch_add(&sh[8 + e], c[e], __ATOMIC_RELAXED, __HIP_MEMORY_SCOPE_WORKGROUP); } }
        __syncthreads();
        if (tid == 0) { int p = 0; for (int e = 0; e < 8; ++e) { sh[16 + e] = p; sh[32 + e] = 256 * p + sh[8 + e]; p += (sh[e] + 255) >> 8; } sh[24] = p;
            if (vr == 0) { for (int e = 0; e < 9; ++e) psg[e] = sh[16 + e]; } }
        __syncthreads();
        if (wave == 0) {
            const int t = vr * 64 + lane; const unsigned ee = tok_e[t]; const int e0 = ee & 255, e1 = ee >> 8; int s0 = 0, s1 = 0;
            const unsigned long long below = (1ull << lane) - 1ull;
#pragma unroll
            for (int e = 0; e < 8; ++e) { const unsigned long long mk = __ballot((e0 == e) || (e1 == e)); const int rank = __popcll(mk & below); const int o = sh[32 + e] + rank; if (e0 == e) s0 = o; if (e1 == e) s1 = o; }
            tok_s[t] = (v2i){s0, s1}; sh[64 + 2 * lane] = s0; sh[64 + 2 * lane + 1] = s1;
            const f32x2 w = tok_w[t]; const float rs = tok_r[t];
            slot_r[s0] = rs; slot_r[s1] = rs; slot_w[s0] = w.x; slot_w[s1] = w.y;
        }
        __syncthreads();
        for (int rep_ = 0; rep_ < REPS(12); ++rep_) {
            v2u xrow[8][4];
#pragma unroll
            for (int tk = 0; tk < 8; ++tk) { const v2u* xr = (const v2u*)(XB + (size_t)(vr * 64 + wave * 8 + tk) * D) + lane;
#pragma unroll
                for (int j = 0; j < 4; ++j) xrow[tk][j] = xr[64 * j]; }
#pragma unroll
            for (int tk = 0; tk < 8; ++tk) {
                const int i = wave * 8 + tk; const int s0 = sh[64 + 2 * i], s1 = sh[64 + 2 * i + 1];
                unsigned* d0 = (unsigned*)(XG + (size_t)s0 * D) + lane; unsigned* d1 = (unsigned*)(XG + (size_t)s1 * D) + lane;
#pragma unroll
                for (int j = 0; j < 4; ++j) { const v2u v = xrow[tk][j]; const unsigned w = pg8::pk4_fp8(bflo(v.x), bfhi(v.x), bflo(v.y), bfhi(v.y)); d0[64 * j] = w; d1[64 * j] = w; }
            }
        }
        for (int e = 0; e < 8; ++e) {
            const int tot = sh[e], base = 256 * sh[16 + e] + tot, npad = 256 * (sh[16 + e + 1] - sh[16 + e]) - tot;
            for (int pr = vcu; pr < npad; pr += G) { const int row = base + pr;
                if (tid < 64) ((v4u*)(XG + (size_t)row * D))[tid] = (v4u){0u, 0u, 0u, 0u};
                if (tid == 0) { slot_r[row] = 0.f; slot_w[row] = 0.f; } }
        }
        __syncthreads();
        SEAM(12);
    }
    {
        const int pu = 13;
        if (IN(pu) || IN(pu + 1)) {
            MOE_PTRS();
            int psv = (lane < 9) ? psg[lane] : 0;
            pg8::MoeOrder<true> Su; pg8::MoeOrder<false> Sd;
#pragma unroll
            for (int e = 0; e < 9; ++e) { Su.ps[e] = __builtin_amdgcn_readlane(psv, e); Sd.ps[e] = Su.ps[e]; }
            const int NP = Su.ps[8];
            if (IN(pu)) {
                Su.p_lo = 0; Su.np = NP; Su.nN = 2 * FFE / 256; Su.nwg = NP * Su.nN; Su.G = G; Su.c = bid;
                pg8::Gemm g{(const bf16*)XG, (const bf16*)(wsp + WS_WM13), D / 2, D / 2};
                pg8::EpiUp<true> E{slot_r, HC, FFE, nullptr, 0};
                for (int rep_ = 0; rep_ < REPS(pu); ++rep_)
                pg8::gemm_phase<pg8::EpiUp<true>, pg8::MoeOrder<true>, true, true, true>(lds + RING_OFF, g, Su, E);
                SEAM(pu);
            }
            if (IN(pu + 1)) {
                const int npm = NP < pg8::TAIL_P0 ? NP : pg8::TAIL_P0;
                Sd.p_lo = 0; Sd.np = npm; Sd.nN = D / 256; Sd.nwg = npm * Sd.nN; Sd.G = G; Sd.c = bid;
                pg8::MoeTailOrder St; St.ntail = NP - npm; St.G = G; St.c = bid;
#pragma unroll
                for (int e = 0; e < 9; ++e) St.ps[e] = Sd.ps[e];
                for (int rep_ = 0; rep_ < REPS(pu + 1); ++rep_) {
                { pg8::Gemm g{(const bf16*)HC, (const bf16*)(wsp + WS_WM2), FFE / 2, FFE / 2};
                  pg8::EpiDownMoeT<false> E{slot_w, Y};
                  pg8::gemm_phase<pg8::EpiDownMoeT<false>, pg8::MoeOrder<false>, true, true, true>(lds + RING_OFF, g, Sd, E); }
                { pg8::Gemm g{(const bf16*)HC, (const bf16*)(wsp + WS_WM2), 256, FFE / 2};
                  pg8::EpiDownMoeT<true> E{slot_w, PT};
                  pg8::gemm_phase<pg8::EpiDownMoeT<true>, pg8::MoeTailOrder, true, true, true>(lds + RING_OFF, g, St, E); }
                }
                SEAM(pu + 1);
            }
        }
    }
    if (IN(15)) {
        MOE_PTRS();
        const float* gf = args.in[30]; float* out = args.out;
        f32x4 gv[4];
#pragma unroll
        for (int j = 0; j < 4; ++j) gv[j] = *((const f32x4*)gf + lane + 64 * j);
        for (int rep_ = 0; rep_ < REPS(15); ++rep_)
        for (int m0 = gw; m0 < S; m0 += 4 * NGW) {
            v2i sl[4];
#pragma unroll
            for (int b = 0; b < 4; ++b) sl[b] = tok_s[m0 + b * NGW];
            v2u xa[4][4]; unsigned ya[4][2][4];
#pragma unroll
            for (int b = 0; b < 4; ++b) {
                const v2u* xr = (const v2u*)(XB + (size_t)(m0 + b * NGW) * D) + lane;
#pragma unroll
                for (int j = 0; j < 4; ++j) xa[b][j] = xr[64 * j];
#pragma unroll
                for (int q = 0; q < 2; ++q) { const int sq = q ? sl[b].y : sl[b].x; const unsigned* y = (const unsigned*)(Y + (size_t)(sq < pg8::TAIL_P0 * 256 ? sq : 0) * D) + lane;
#pragma unroll
                    for (int j = 0; j < 4; ++j) ya[b][q][j] = y[64 * j]; }
            }
#pragma unroll
            for (int b = 0; b < 4; ++b) {
                const int m = m0 + b * NGW;
                f32x4 v[4]; float s = 0.f;
#pragma unroll
                for (int j = 0; j < 4; ++j) { const v2u a = xa[b][j]; v[j] = (f32x4){bflo(a.x), bfhi(a.x), bflo(a.y), bfhi(a.y)}; }
#pragma unroll
                for (int q = 0; q < 2; ++q) {
                    const int sq = q ? sl[b].y : sl[b].x;
                    if (sq < pg8::TAIL_P0 * 256) {
#pragma unroll
                        for (int j = 0; j < 4; ++j) { const unsigned a = ya[b][q][j]; const f32x2 lo = __builtin_amdgcn_cvt_pk_f32_fp8((int)a, false), hi = __builtin_amdgcn_cvt_pk_f32_fp8((int)a, true);
                            v[j].x += lo.x * pg8::Y8_INV; v[j].y += lo.y * pg8::Y8_INV; v[j].z += hi.x * pg8::Y8_INV; v[j].w += hi.y * pg8::Y8_INV; }
                    } else {
                        const int pl = (sq >> 8) - pg8::TAIL_P0, r = sq & 255;
                        for (int ks = 0; ks < pg8::TAIL_NKS; ++ks) { const unsigned* y = (const unsigned*)(PT + ((size_t)(ks * 8 + pl) * 256 + r) * D) + lane;
#pragma unroll
                            for (int j = 0; j < 4; ++j) { const unsigned a = y[64 * j]; const f32x2 lo = __builtin_amdgcn_cvt_pk_f32_fp8((int)a, false), hi = __builtin_amdgcn_cvt_pk_f32_fp8((int)a, true);
                                v[j].x += lo.x * pg8::Y8_INV; v[j].y += lo.y * pg8::Y8_INV; v[j].z += hi.x * pg8::Y8_INV; v[j].w += hi.y * pg8::Y8_INV; } }
                    }
                }
#pragma unroll
                for (int j = 0; j < 4; ++j) s += (v[j].x * v[j].x + v[j].y * v[j].y) + (v[j].z * v[j].z + v[j].w * v[j].w);
                const float rstd = __builtin_amdgcn_rsqf(wave_sum(s) * (1.f / D) + RMS_EPS);
                f32x4* o = (f32x4*)(out + (size_t)m * D) + lane;
#pragma unroll
                for (int j = 0; j < 4; ++j) o[64 * j] = v[j] * rstd * gv[j];
            }
        }
    }
#undef IN
#undef SEAM
}

constexpr int N_PHASES = 16;
extern "C" void kernel_launch(void* const* d_in, const int* in_sizes, int n_in, void* d_out, int out_size, void* d_ws, size_t ws_size, hipStream_t stream) {
    static int grid = 0;
    if (grid == 0) {
        if (n_in != 31 || in_sizes[0] != S * D || out_size != S * D || ws_size < WS_END) { fprintf(stderr, "kernel_launch: unexpected shapes (n_in %d, in0 %d, out %d, ws %zu < %zu); nothing launched\n", n_in, n_in > 0 ? in_sizes[0] : -1, out_size, ws_size, (size_t)WS_END); grid = -1; return; }
        int dev = 0, cus = 0, per_cu = 0;
        if (hipGetDevice(&dev) != hipSuccess || hipDeviceGetAttribute(&cus, hipDeviceAttributeMultiprocessorCount, dev) != hipSuccess) { grid = -1; return; }
        if (hipFuncSetAttribute((const void*)fwd, hipFuncAttributeMaxDynamicSharedMemorySize, LDS_BYTES) != hipSuccess) { fprintf(stderr, "kernel_launch: hipFuncSetAttribute failed\n"); grid = -1; return; }
        if (hipOccupancyMaxActiveBlocksPerMultiprocessor(&per_cu, (const void*)fwd, NWAVES * 64, LDS_BYTES) != hipSuccess || per_cu < 1) fprintf(stderr, "kernel_launch: occupancy query reports %d workgroups per CU\n", per_cu);
        (void)hipGetLastError();
        grid = cus;
        if (grid > 256) grid = 256;
    }
    if (grid < 0) return;
    if (hipMemsetAsync((char*)d_ws + WS_CTL, 0, CTL_ZERO_BYTES, stream) != hipSuccess) return;
    Args a{};
    for (int i = 0; i < 31; ++i) a.in[i] = (const float*)d_in[i];
    a.out = (float*)d_out; a.ws = (unsigned char*)d_ws;
#if MK_PER_PHASE
    for (int p = 0; p < N_PHASES; ++p) { a.ph_lo = p; a.ph_hi = p + 1; hipLaunchKernelGGL(fwd, dim3(grid), dim3(NWAVES * 64), LDS_BYTES, stream, a); }
#else
    a.ph_lo = 0; a.ph_hi = N_PHASES;
    hipLaunchKernelGGL(fwd, dim3(grid), dim3(NWAVES * 64), LDS_BYTES, stream, a);
#endif
}
```

```cpp
#include <hip/hip_runtime.h>
#include <cstdio>
#include <cstdint>

#ifndef MK_PER_PHASE
#define MK_PER_PHASE 0
#endif

namespace pg8 {
#define PG8_LAS __attribute__((address_space(3)))
#define PG8_GAS __attribute__((address_space(1)))
typedef unsigned short bf16_t;
typedef short bf16x8 __attribute__((ext_vector_type(8)));
typedef float f32x4 __attribute__((ext_vector_type(4)));
typedef unsigned u32x4 __attribute__((ext_vector_type(4)));
typedef unsigned u32x2 __attribute__((ext_vector_type(2)));
typedef int v4i_t __attribute__((ext_vector_type(4)));
typedef int v8i_t __attribute__((ext_vector_type(8)));
constexpr int BM = 256, BK = 64, HALF = 128, HTB = HALF * BK * 2  , STAGE_BYTES = 8 * HTB, NXCD = 8, WGM = 8;

__host__ __device__ __forceinline__ int lds_byte(int r, int c) { const int st = (r >> 4) * 2 + (c >> 5), rr = r & 15, cc = c & 31, ob = rr * 64 + cc * 2; return st * 1024 + (ob ^ (((ob >> 9) & 1) << 5)); }
__host__ __device__ __forceinline__ void stage_rc(int b, int& R, int& C) { const int st = b / 1024, sb = b % 1024, swz = sb ^ (((sb >> 9) & 1) << 5); R = (st >> 1) * 16 + swz / 64; C = (st & 1) * 32 + (swz % 64) / 2; }
__host__ __device__ __forceinline__ int perm32(int rho) { const int n = rho >> 4, i = rho & 15; return 8 * (i >> 2) + 4 * n + (i & 3); }

struct Unit { int pa, pn, bn, po, koff; };
struct NoPre {};
struct Gemm { const bf16_t* A; const bf16_t* Bt; int K, pitch; };

struct StaticOrder {
    int nM, nN, nwg, G, c, pn0;
    __device__ __forceinline__ void init(int nM_, int nN_, int G_, int c_, int pn0_ = 0) { nM = nM_; nN = nN_; nwg = nM * nN; G = G_; c = c_; pn0 = pn0_; }
    __device__ __forceinline__ bool next(int i, Unit& u) const {
        const long L = (long)i * G + c; if (L >= nwg) return false;
        int wgid = (int)L; { const int q = nwg / NXCD, r = nwg % NXCD, xcd = wgid % NXCD, off = wgid / NXCD; wgid = (xcd < r ? xcd * (q + 1) : r * (q + 1) + (xcd - r) * q) + off; }
        const int nig = WGM * nN, gid = wgid / nig, fm = gid * WGM, gsz = (nM - fm) < WGM ? (nM - fm) : WGM;
        u.pa = fm + ((wgid % nig) % gsz); u.pn = pn0 + (wgid % nig) / gsz; u.bn = u.pn; u.po = u.pa; u.koff = 0; return true;
    }
};
template <bool UP> struct MoeOrder {
    int p_lo, np, nN, nwg, G, c; int ps[9];
    __device__ __forceinline__ bool next(int i, Unit& u) const {
        const long L = (long)i * G + c; if (L >= nwg) return false;
        int wgid = (int)L; { const int q = nwg / NXCD, r = nwg % NXCD, xcd = wgid % NXCD, off = wgid / NXCD; wgid = (xcd < r ? xcd * (q + 1) : r * (q + 1) + (xcd - r) * q) + off; }
        const int nig = WGM * nN, gid = wgid / nig, fm = gid * WGM, gsz = (np - fm) < WGM ? (np - fm) : WGM;
        const int pl = fm + ((wgid % nig) % gsz), pn = (wgid % nig) / gsz, p = p_lo + pl;
        int e = 0;
#pragma unroll
        for (int j = 1; j < 8; ++j) e += (ps[j] <= p) ? 1 : 0;
        u.pn = pn; u.bn = e * nN + pn; u.pa = UP ? p : pl; u.po = UP ? pl : p; u.koff = 0; return true;
    }
};

typedef __bf16 bf16v2_t __attribute__((ext_vector_type(2)));
typedef float f32v2_t __attribute__((ext_vector_type(2)));
constexpr int TAIL_P0 = 128, TAIL_NKS = 7;
struct MoeTailOrder {
    int ntail, G, c; int ps[9];
    __device__ __forceinline__ bool next(int i, Unit& u) const {
        const long L = (long)i * G + c; if (L >= (long)ntail * 4 * TAIL_NKS) return false;
        const int ks = (int)L % TAIL_NKS, tile = (int)L / TAIL_NKS, pl = tile >> 2, pn = tile & 3, p = TAIL_P0 + pl;
        int e = 0;
#pragma unroll
        for (int j = 1; j < 8; ++j) e += (ps[j] <= p) ? 1 : 0;
        u.pa = p; u.pn = pn; u.bn = e * 4 + pn; u.po = ks * 8 + pl; u.koff = ks * 512; return true;
    }
};

__device__ __forceinline__ unsigned cvt_pk_bf16(float lo, float hi) { const f32v2_t f = {lo, hi}; const bf16v2_t b = __builtin_convertvector(f, bf16v2_t); return __builtin_bit_cast(unsigned, b); }
__device__ __forceinline__ float bflo(unsigned w) { return __uint_as_float(w << 16); }
__device__ __forceinline__ float bfhi(unsigned w) { return __uint_as_float(w & 0xffff0000u); }
__device__ __forceinline__ float sigmoid_f(float x) { return __builtin_amdgcn_rcpf(1.0f + __builtin_amdgcn_exp2f(-1.4426950408889634f * x)); }
__device__ __forceinline__ u32x4 pack8(const f32x4& a, const f32x4& b) { u32x4 w; w.x = cvt_pk_bf16(a[0], a[1]); w.y = cvt_pk_bf16(a[2], a[3]); w.z = cvt_pk_bf16(b[0], b[1]); w.w = cvt_pk_bf16(b[2], b[3]); return w; }
__device__ __forceinline__ unsigned pk4_fp8(float a, float b, float c, float d) {
    a = __builtin_amdgcn_fmed3f(a, -448.f, 448.f); b = __builtin_amdgcn_fmed3f(b, -448.f, 448.f); c = __builtin_amdgcn_fmed3f(c, -448.f, 448.f); d = __builtin_amdgcn_fmed3f(d, -448.f, 448.f);
    int w = 0; w = __builtin_amdgcn_cvt_pk_fp8_f32(a, b, w, false); w = __builtin_amdgcn_cvt_pk_fp8_f32(c, d, w, true); return (unsigned)w; }
__device__ __forceinline__ void unpack8(const u32x4& w, f32x4& a, f32x4& b) { a[0] = bflo(w.x); a[1] = bfhi(w.x); a[2] = bflo(w.y); a[3] = bfhi(w.y); b[0] = bflo(w.z); b[1] = bfhi(w.z); b[2] = bflo(w.w); b[3] = bfhi(w.w); }
__device__ __forceinline__ void rows_rstd(const float* ss, int row0, int fq, float (&rs)[2][4]) {
    f32x4 pv[2][4];
#pragma unroll
    for (int ai = 0; ai < 2; ++ai)
#pragma unroll
        for (int m = 0; m < 4; ++m) pv[ai][m] = *(const f32x4*)(ss + (size_t)(row0 + ai * HALF + m * 16) * 16 + 4 * fq);
#pragma unroll
    for (int ai = 0; ai < 2; ++ai)
#pragma unroll
        for (int m = 0; m < 4; ++m) { const f32x4 v = pv[ai][m]; float s = (v[0] + v[1]) + (v[2] + v[3]); s += __shfl_xor(s, 16); s += __shfl_xor(s, 32); rs[ai][m] = __builtin_amdgcn_rsqf(s * (1.0f / 1024.0f) + 1e-6f); }
}

__device__ __forceinline__ void rows_rstd_lds(const PG8_LAS float* tab, int pa0, const float* ss, const Unit& u, int wr, int fr, int fq, float (&rs)[2][4]) {
    if (u.po == pa0) {
#pragma unroll
        for (int ai = 0; ai < 2; ++ai)
#pragma unroll
            for (int m = 0; m < 4; ++m) rs[ai][m] = tab[wr * 64 + fr + ai * HALF + m * 16];
    } else rows_rstd(ss, u.po * BM + wr * 64 + fr, fq, rs);
}

template <int PART> struct EpiG1 {
    static constexpr bool HAS_MID = false, ACC_INIT = false;
    const float* ss; bf16_t *a, *v, *sb, *R, *Gt; const PG8_LAS float* rtab; int pa0;
    typedef NoPre Pre; __device__ __forceinline__ void pre(NoPre&, const Unit&, int, int) const {}
    __device__ __forceinline__ void mid(f32x4 (&)[2][2][4][2], const Unit&, int, int, int, int) const {}
    __device__ __forceinline__ void operator()(const f32x4 (&acc)[2][2][4][2], const Unit& u, int wr, int wc, int fr, int fq, const NoPre&) const {
        const int row0 = u.po * BM + wr * 64 + fr, cw = wc * 32 + 8 * fq, pn = u.pn;
        float rsv[2][4]; rows_rstd_lds(rtab, pa0, ss, u, wr, fr, fq, rsv);
#pragma unroll
        for (int ai = 0; ai < 2; ++ai)
#pragma unroll
            for (int m = 0; m < 4; ++m) {
                const int row = row0 + ai * HALF + m * 16;
                const float rs = rsv[ai][m];
                const float rsn = rs * -1.4426950408889634f, rs2 = rs * rs;
                if (PART == 0 && pn < 4) {
                    f32x4 o[2];
#pragma unroll
                    for (int hh = 0; hh < 2; ++hh)
#pragma unroll
                        for (int j = 0; j < 4; j += 2) { const f32x4& a1 = acc[ai][0][m][hh]; const f32x4& a2 = acc[ai][1][m][hh];
                            const f32v2_t av = {a1[j], a1[j + 1]}, gv = {a2[j], a2[j + 1]}; const f32v2_t pe = gv * rsn;
                            f32v2_t e; e.x = __builtin_amdgcn_exp2f(pe.x); e.y = __builtin_amdgcn_exp2f(pe.y); const f32v2_t d = e + 1.0f;
                            f32v2_t r; r.x = __builtin_amdgcn_rcpf(d.x); r.y = __builtin_amdgcn_rcpf(d.y); const f32v2_t ov = (av * rs) * r; o[hh][j] = ov.x; o[hh][j + 1] = ov.y; }
                    *(u32x4*)(a + (size_t)row * 512 + pn * 128 + cw) = pack8(o[0], o[1]);
                } else if (PART == 0 && pn < 8) {
                    *(u32x4*)(v + (size_t)row * 512 + (pn - 4) * 128 + cw) = pack8((acc[ai][0][m][0] * acc[ai][1][m][0]) * rs2, (acc[ai][0][m][1] * acc[ai][1][m][1]) * rs2);
                } else if (PART == 0) {
                    bf16_t* d = sb + (size_t)row * 512 + (pn - 8) * 256 + cw;
                    *(u32x4*)d = pack8(acc[ai][0][m][0] * rs, acc[ai][0][m][1] * rs); *(u32x4*)(d + 128) = pack8(acc[ai][1][m][0] * rs, acc[ai][1][m][1] * rs);
                } else {
                    f32x4 rr[2], gg[2];
#pragma unroll
                    for (int hh = 0; hh < 2; ++hh)
#pragma unroll
                        for (int j = 0; j < 4; j += 2) { const f32x4& a1 = acc[ai][0][m][hh]; const f32x4& a2 = acc[ai][1][m][hh];
                            f32v2_t ga = (f32v2_t){a1[j], a1[j + 1]} * rs, gb = (f32v2_t){a2[j], a2[j + 1]} * rs;
                            ga.x = __builtin_amdgcn_fmed3f(ga.x, -80.f, 80.f); ga.y = __builtin_amdgcn_fmed3f(ga.y, -80.f, 80.f); gb.x = __builtin_amdgcn_fmed3f(gb.x, -80.f, 80.f); gb.y = __builtin_amdgcn_fmed3f(gb.y, -80.f, 80.f);
                            const f32v2_t pa = ga * -1.4426950408889634f, pb = gb * -1.4426950408889634f;
                            f32v2_t ea, eb; ea.x = __builtin_amdgcn_exp2f(pa.x); ea.y = __builtin_amdgcn_exp2f(pa.y); eb.x = __builtin_amdgcn_exp2f(pb.x); eb.y = __builtin_amdgcn_exp2f(pb.y);
                            const f32v2_t da = ea + 1.0f, db = eb + 1.0f;
                            f32v2_t ia, ib; ia.x = __builtin_amdgcn_rcpf(da.x); ia.y = __builtin_amdgcn_rcpf(da.y); ib.x = __builtin_amdgcn_rcpf(db.x); ib.y = __builtin_amdgcn_rcpf(db.y);
                            const f32v2_t rv = db * ia; rr[hh][j] = rv.x; rr[hh][j + 1] = rv.y; gg[hh][j] = ib.x; gg[hh][j + 1] = ib.y; }
                    const size_t o = (size_t)row * 1024 + (pn - 10) * 128 + cw;
                    *(u32x4*)(R + o) = pack8(rr[0], rr[1]); *(u32x4*)(Gt + o) = pack8(gg[0], gg[1]);
                }
            }
    }
};
struct EpiG2 {
    static constexpr bool HAS_MID = true, ACC_INIT = false;
    const bf16_t *R, *Gt; bf16_t* out;
    typedef NoPre Pre; __device__ __forceinline__ void pre(NoPre&, const Unit&, int, int) const {}
    __device__ __forceinline__ void mid(f32x4 (&acc)[2][2][4][2], const Unit& u, int wr, int wc, int fr, int fq) const {
        int po_ = u.po; asm volatile("" : "+s"(po_));
        const int row0 = po_ * BM + wr * 64 + fr, cw = u.pn * BM + wc * 32 + 8 * fq;
#pragma unroll
        for (int ai = 0; ai < 2; ++ai) {
            u32x4 gv[4][2];
#pragma unroll
            for (int m = 0; m < 4; ++m)
#pragma unroll
                for (int bj = 0; bj < 2; ++bj) gv[m][bj] = *(const u32x4*)(R + (size_t)(row0 + ai * HALF + m * 16) * 1024 + cw + bj * HALF);
#pragma unroll
            for (int m = 0; m < 4; ++m)
#pragma unroll
                for (int bj = 0; bj < 2; ++bj) { f32x4 g0, g1; unpack8(gv[m][bj], g0, g1); acc[ai][bj][m][0] *= g0; acc[ai][bj][m][1] *= g1; }
            asm volatile("" ::: "memory");
        }
    }
    __device__ __forceinline__ void operator()(const f32x4 (&acc)[2][2][4][2], const Unit& u, int wr, int wc, int fr, int fq, const NoPre&) const {
        int po_ = u.po; asm volatile("" : "+s"(po_));
        const int row0 = po_ * BM + wr * 64 + fr, cw = u.pn * BM + wc * 32 + 8 * fq;
#pragma unroll
        for (int ai = 0; ai < 2; ++ai) {
            u32x4 gv[4][2];
#pragma unroll
            for (int m = 0; m < 4; ++m)
#pragma unroll
                for (int bj = 0; bj < 2; ++bj) gv[m][bj] = *(const u32x4*)(Gt + (size_t)(row0 + ai * HALF + m * 16) * 1024 + cw + bj * HALF);
#pragma unroll
            for (int m = 0; m < 4; ++m)
#pragma unroll
                for (int bj = 0; bj < 2; ++bj) { f32x4 g0, g1; unpack8(gv[m][bj], g0, g1);
                    *(u32x4*)(out + (size_t)(row0 + ai * HALF + m * 16) * 1024 + cw + bj * HALF) = pack8(acc[ai][bj][m][0] * g0, acc[ai][bj][m][1] * g1); }
            asm volatile("" ::: "memory");
        }
    }
};
template <bool AUX, bool XF32> struct EpiRes {
    static constexpr bool HAS_MID = false, ACC_INIT = true;
    const float* xin; bf16_t* xb; float* ss;
    typedef NoPre Pre; __device__ __forceinline__ void pre(NoPre&, const Unit&, int, int) const {}
    __device__ __forceinline__ void mid(f32x4 (&)[2][2][4][2], const Unit&, int, int, int, int) const {}
    __device__ __forceinline__ void init(f32x4 (&acc)[2][2][4][2], const Unit& u, int wr, int wc, int fr, int fq) const {
        const int row0 = u.po * BM + wr * 64 + fr, cw = u.pn * BM + wc * 32 + 8 * fq;
#pragma unroll
        for (int ai = 0; ai < 2; ++ai)
#pragma unroll
            for (int m = 0; m < 4; ++m)
#pragma unroll
                for (int bj = 0; bj < 2; ++bj) { const size_t o = (size_t)(row0 + ai * HALF + m * 16) * 1024 + cw + bj * HALF;
                    if (XF32) { acc[ai][bj][m][0] = *(const f32x4*)(xin + o); acc[ai][bj][m][1] = *(const f32x4*)(xin + o + 4); }
                    else unpack8(*(const u32x4*)(xb + o), acc[ai][bj][m][0], acc[ai][bj][m][1]); }
    }
    __device__ __forceinline__ void operator()(const f32x4 (&acc)[2][2][4][2], const Unit& u, int wr, int wc, int fr, int fq, const NoPre&) const {
        const int row0 = u.po * BM + wr * 64 + fr, cw = u.pn * BM + wc * 32 + 8 * fq;
#pragma unroll
        for (int ai = 0; ai < 2; ++ai)
#pragma unroll
            for (int m = 0; m < 4; ++m) {
                const int row = row0 + ai * HALF + m * 16; const size_t o = (size_t)row * 1024 + cw; float q = 0.f;
#pragma unroll
                for (int bj = 0; bj < 2; ++bj) {
                    const f32x4 o0 = acc[ai][bj][m][0], o1 = acc[ai][bj][m][1];
                    if (AUX) q += (o0[0] * o0[0] + o0[1] * o0[1]) + (o0[2] * o0[2] + o0[3] * o0[3]) + (o1[0] * o1[0] + o1[1] * o1[1]) + (o1[2] * o1[2] + o1[3] * o1[3]);
                    *(u32x4*)(xb + o + bj * HALF) = pack8(o0, o1);
                }
                if (AUX) { q += __shfl_xor(q, 16); q += __shfl_xor(q, 32); if (fq == 0) ss[(size_t)row * 16 + u.pn * 4 + wc] = q; }
            }
    }
};
constexpr float F8_WSCALE = 64.0f, F8_WINV = 1.0f / 64.0f;
template <bool MOE> struct EpiUp {
    static constexpr bool HAS_MID = false, ACC_INIT = false;
    const float* rsrc; void* hid; int ld; const PG8_LAS float* rtab; int pa0;
    struct Pre { float rs[2][4]; };
    __device__ __forceinline__ void pre(Pre& pf, const Unit& u, int wr, int fr) const {
        if (MOE) { const int row0 = u.po * BM + wr * 64 + fr;
#pragma unroll
            for (int ai = 0; ai < 2; ++ai)
#pragma unroll
                for (int m = 0; m < 4; ++m) pf.rs[ai][m] = rsrc[row0 + ai * HALF + m * 16]; } }
    __device__ __forceinline__ void mid(f32x4 (&)[2][2][4][2], const Unit&, int, int, int, int) const {}
    __device__ __forceinline__ void operator()(const f32x4 (&acc)[2][2][4][2], const Unit& u, int wr, int wc, int fr, int fq, const Pre& pf) const {
        const int row0 = u.po * BM + wr * 64 + fr, cw = u.pn * HALF + wc * 32 + 8 * fq;
        float rsv[2][4];
        if (MOE) {
#pragma unroll
            for (int ai = 0; ai < 2; ++ai)
#pragma unroll
                for (int m = 0; m < 4; ++m) rsv[ai][m] = pf.rs[ai][m] * F8_WINV;
        } else rows_rstd_lds(rtab, pa0, rsrc, u, wr, fr, fq, rsv);
#pragma unroll
        for (int ai = 0; ai < 2; ++ai)
#pragma unroll
            for (int m = 0; m < 4; ++m) {
                const int row = row0 + ai * HALF + m * 16;
                const float rs = rsv[ai][m];
                const float rsn = rs * -1.4426950408889634f, rs2 = rs * rs;
                f32x4 o0, o1;
#pragma unroll
                for (int hh = 0; hh < 2; ++hh)
#pragma unroll
                    for (int j = 0; j < 4; j += 2) {
                        const f32x4& a1 = acc[ai][0][m][hh]; const f32x4& a3 = acc[ai][1][m][hh];
                        const f32v2_t av = {a1[j], a1[j + 1]}, bv = {a3[j], a3[j + 1]};
                        const f32v2_t pe = av * rsn, pq = (av * bv) * rs2;
                        f32v2_t e; e.x = __builtin_amdgcn_exp2f(pe.x); e.y = __builtin_amdgcn_exp2f(pe.y);
                        const f32v2_t d = e + 1.0f; f32v2_t r; r.x = __builtin_amdgcn_rcpf(d.x); r.y = __builtin_amdgcn_rcpf(d.y);
                        const f32v2_t o = pq * r;
                        if (hh == 0) { o0[j] = o.x; o0[j + 1] = o.y; } else { o1[j] = o.x; o1[j + 1] = o.y; }
                    }
                if (MOE) { u32x2 w; w.x = pk4_fp8(o0[0], o0[1], o0[2], o0[3]); w.y = pk4_fp8(o1[0], o1[1], o1[2], o1[3]); *(u32x2*)((unsigned char*)hid + (size_t)row * ld + cw) = w; }
                else *(u32x4*)((bf16_t*)hid + (size_t)row * ld + cw) = pack8(o0, o1);
            }
    }
};
constexpr float Y8_SCALE = 16.0f, Y8_INV = 1.0f / 16.0f;
template <bool TAIL> struct EpiDownMoeT {
    static constexpr bool HAS_MID = false, ACC_INIT = false;
    const float* w; unsigned char* Y;
    struct Pre { float ws[2][4]; };
    __device__ __forceinline__ void pre(Pre& pf, const Unit& u, int wr, int fr) const {
        const int row0 = u.po * BM + wr * 64 + fr;
#pragma unroll
        for (int ai = 0; ai < 2; ++ai)
#pragma unroll
            for (int m = 0; m < 4; ++m) { const int row = row0 + ai * HALF + m * 16; pf.ws[ai][m] = w[TAIL ? row - (u.po - (u.po & 7)) * BM + TAIL_P0 * BM : row]; } }
    __device__ __forceinline__ void mid(f32x4 (&)[2][2][4][2], const Unit&, int, int, int, int) const {}
    __device__ __forceinline__ void operator()(const f32x4 (&acc)[2][2][4][2], const Unit& u, int wr, int wc, int fr, int fq, const Pre& pf) const {
        const int row0 = u.po * BM + wr * 64 + fr, cw = u.pn * BM + wc * 32 + 8 * fq;
#pragma unroll
        for (int ai = 0; ai < 2; ++ai)
#pragma unroll
            for (int m = 0; m < 4; ++m) {
                const int row = row0 + ai * HALF + m * 16; const float ws = pf.ws[ai][m] * (F8_WINV * Y8_SCALE); const size_t o = (size_t)row * 1024 + cw;
#pragma unroll
                for (int bj = 0; bj < 2; ++bj) { const f32x4 v0 = acc[ai][bj][m][0] * ws, v1 = acc[ai][bj][m][1] * ws; u32x2 pk; pk.x = pk4_fp8(v0[0], v0[1], v0[2], v0[3]); pk.y = pk4_fp8(v1[0], v1[1], v1[2], v1[3]); *(u32x2*)(Y + o + bj * HALF) = pk; }
            }
    }
};

template <class Epi, class Sched, bool ALIGN_EPI = false, bool SP2 = false, bool F8 = false>
__device__ __forceinline__ void gemm_phase(PG8_LAS unsigned char* lds, const Gemm g, const Sched& S, const Epi& E) {
    int tid_ = threadIdx.x; asm volatile("" : "+v"(tid_));
    const int tid = tid_, wid = __builtin_amdgcn_readfirstlane(tid >> 6), lane = tid & 63, wr = wid >> 2, wc = wid & 3, fr = lane & 15, fq = lane >> 4;
    const int K = g.pitch, nt = g.K / BK;
    unsigned voffA[2], voffB[2];
#pragma unroll
    for (int i = 0; i < 2; ++i) { int R, C; stage_rc(tid * 16 + i * 8192, R, C); const int Rb = (R & ~31) + perm32(R & 31);
        voffA[i] = (unsigned)(R * K + C) * 2u; voffB[i] = (unsigned)(Rb * K + C) * 2u; }
    const size_t kstep = (size_t)(BK * 2);
    const size_t hstep = (size_t)HALF * K * 2;
    const size_t tstep = 2 * hstep;
    const unsigned ldsw = (unsigned)wid * 1024u;
    const int aoff = lds_byte(wr * 64 + fr, fq * 8), boff = lds_byte(wc * 32 + fr, fq * 8);
#define PG8_SA(b, h) (((b) * 2 + (h)) * HTB)
#define PG8_SB(b, h) ((4 + (b) * 2 + (h)) * HTB)
#define PG8_STAGE(bufoff, gbase, voff) do { _Pragma("unroll") for (int _i = 0; _i < 2; ++_i) \
        __builtin_amdgcn_global_load_lds((const PG8_GAS unsigned*)((gbase) + (voff)[_i]), (PG8_LAS unsigned*)(lds + (bufoff) + ldsw + _i * 8192), 16, 0, 0); } while (0)
#define PG8_LDA(dst, b, h) do { _Pragma("unroll") for (int m = 0; m < 4; ++m) _Pragma("unroll") for (int k = 0; k < 2; ++k) dst[m][k] = *(const PG8_LAS bf16x8*)(lds + PG8_SA(b, h) + aoff + m * 2048 + k * 1024); } while (0)
#define PG8_LDB(dst, b, h) do { _Pragma("unroll") for (int n = 0; n < 2; ++n) _Pragma("unroll") for (int k = 0; k < 2; ++k) dst[n][k] = *(const PG8_LAS bf16x8*)(lds + PG8_SB(b, h) + boff + n * 2048 + k * 1024); } while (0)
#define PG8_MMA(ai, bj, At, Bt) do { __builtin_amdgcn_s_setprio(1); if constexpr (F8) { _Pragma("unroll") for (int m = 0; m < 4; ++m) _Pragma("unroll") for (int n = 0; n < 2; ++n) { \
            const v8i_t a8 = __builtin_shufflevector(__builtin_bit_cast(v4i_t, At[m][0]), __builtin_bit_cast(v4i_t, At[m][1]), 0, 1, 2, 3, 4, 5, 6, 7), b8 = __builtin_shufflevector(__builtin_bit_cast(v4i_t, Bt[n][0]), __builtin_bit_cast(v4i_t, Bt[n][1]), 0, 1, 2, 3, 4, 5, 6, 7); \
            asm volatile("v_mfma_scale_f32_16x16x128_f8f6f4 %0, %1, %2, %0, %3, %3 op_sel_hi:[0,0,0]" : "+v"(acc[ai][bj][m][n]) : "v"(b8), "v"(a8), "v"(f8_unit_scale)); } } else { \
        _Pragma("unroll") for (int m = 0; m < 4; ++m) _Pragma("unroll") for (int n = 0; n < 2; ++n) _Pragma("unroll") for (int k = 0; k < 2; ++k) \
        acc[ai][bj][m][n] = __builtin_amdgcn_mfma_f32_16x16x32_bf16(Bt[n][k], At[m][k], acc[ai][bj][m][n], 0, 0, 0); } __builtin_amdgcn_s_setprio(0); } while (0)
#define PG8_WAIT_V(n) asm volatile("s_waitcnt vmcnt(" #n ")" ::: "memory")
#define PG8_WAIT_L(n) asm volatile("s_waitcnt lgkmcnt(" #n ")" ::: "memory")
#define PG8_BAR __builtin_amdgcn_s_barrier()
#define PG8_SCHED __builtin_amdgcn_sched_barrier(0)
    Unit cur, nxt; int ui = 0;
    if (!S.next(0, cur)) return;
    cur.pa = __builtin_amdgcn_readfirstlane(cur.pa); cur.pn = __builtin_amdgcn_readfirstlane(cur.pn); cur.bn = __builtin_amdgcn_readfirstlane(cur.bn); cur.po = __builtin_amdgcn_readfirstlane(cur.po); cur.koff = __builtin_amdgcn_readfirstlane(cur.koff);
    f32x4 acc[2][2][4][2];
    typename Epi::Pre pf;
    const int f8_unit_scale = 0x7F7F7F7F;
    (void)f8_unit_scale;
    if constexpr (Epi::ACC_INIT) E.init(acc, cur, wr, wc, fr, fq);
    else {
#pragma unroll
    for (int a = 0; a < 2; ++a)
#pragma unroll
        for (int b = 0; b < 2; ++b)
#pragma unroll
            for (int m = 0; m < 4; ++m)
#pragma unroll
                for (int n = 0; n < 2; ++n) acc[a][b][m][n] = (f32x4){0.f, 0.f, 0.f, 0.f};
    }
    bf16x8 At[4][2], B0[2][2], B1[2][2];
    const PG8_GAS char* cA = (const PG8_GAS char*)g.A + (size_t)cur.pa * tstep + cur.koff; const PG8_GAS char* cB = (const PG8_GAS char*)g.Bt + (size_t)cur.bn * tstep + cur.koff;
    if constexpr (SP2) {
        PG8_STAGE(PG8_SB(0, 0), cB, voffB); PG8_STAGE(PG8_SB(0, 1), cB + hstep, voffB); PG8_STAGE(PG8_SA(0, 0), cA, voffA); PG8_STAGE(PG8_SA(0, 1), cA + hstep, voffA);
        if (wr == 1) PG8_BAR;
        PG8_WAIT_V(2); PG8_BAR;
        PG8_STAGE(PG8_SB(1, 0), cB + kstep, voffB); PG8_STAGE(PG8_SA(1, 0), cA + kstep, voffA); PG8_STAGE(PG8_SB(1, 1), cB + hstep + kstep, voffB);
        PG8_WAIT_V(6); PG8_BAR;
    } else {
        PG8_STAGE(PG8_SB(0, 0), cB, voffB); PG8_STAGE(PG8_SA(0, 0), cA, voffA); PG8_STAGE(PG8_SB(0, 1), cB + hstep, voffB); PG8_STAGE(PG8_SA(0, 1), cA + hstep, voffA);
        if (wr == 1) PG8_BAR;
        PG8_WAIT_V(4); PG8_BAR;
        PG8_STAGE(PG8_SB(1, 0), cB + kstep, voffB); PG8_STAGE(PG8_SA(1, 0), cA + kstep, voffA); PG8_STAGE(PG8_SB(1, 1), cB + hstep + kstep, voffB);
        PG8_WAIT_V(6); PG8_BAR;
    }
    for (;;) {
        const bool has_next = S.next(ui + 1, nxt);
        nxt.pa = __builtin_amdgcn_readfirstlane(nxt.pa); nxt.pn = __builtin_amdgcn_readfirstlane(nxt.pn); nxt.bn = __builtin_amdgcn_readfirstlane(nxt.bn); nxt.po = __builtin_amdgcn_readfirstlane(nxt.po); nxt.koff = __builtin_amdgcn_readfirstlane(nxt.koff);
        const PG8_GAS char* nA = has_next ? (const PG8_GAS char*)g.A + (size_t)nxt.pa * tstep + nxt.koff : cA; const PG8_GAS char* nB = has_next ? (const PG8_GAS char*)g.Bt + (size_t)nxt.bn * tstep + nxt.koff : cB;
        for (int kh = 0; kh < (Epi::HAS_MID ? 2 : 1); ++kh) {
        const int t_lo = Epi::HAS_MID ? kh * (nt >> 1) : 0, t_hi = Epi::HAS_MID ? (kh + 1) * (nt >> 1) : nt;
#pragma unroll 1
        for (int t = t_lo; t < t_hi; t += 2) {
            const bool last = (t == nt - 2);
            if (last) E.pre(pf, cur, wr, fr);
            const PG8_GAS char* a1 = cA + (size_t)(t + 1) * kstep;
            const PG8_GAS char* a2 = last ? nA : cA + (size_t)(t + 2) * kstep; const PG8_GAS char* b2 = last ? nB : cB + (size_t)(t + 2) * kstep;
            const PG8_GAS char* a3 = a2 + kstep; const PG8_GAS char* b3 = b2 + kstep;
            if constexpr (SP2) {
            PG8_LDB(B0, 0, 0); PG8_LDB(B1, 0, 1); PG8_SCHED; PG8_LDA(At, 0, 0); PG8_STAGE(PG8_SA(1, 1), a1 + hstep, voffA);
            PG8_WAIT_V(8); PG8_WAIT_L(0); PG8_BAR; PG8_MMA(0, 0, At, B0); PG8_MMA(0, 1, At, B1); PG8_BAR; PG8_SCHED;
            PG8_LDA(At, 0, 1); PG8_STAGE(PG8_SB(0, 0), b2, voffB); PG8_STAGE(PG8_SB(0, 1), b2 + hstep, voffB); PG8_STAGE(PG8_SA(0, 0), a2, voffA);
            PG8_WAIT_V(8); PG8_WAIT_L(0); PG8_BAR; PG8_MMA(1, 0, At, B0); PG8_MMA(1, 1, At, B1); PG8_BAR; PG8_SCHED;
            PG8_LDB(B0, 1, 0); PG8_LDB(B1, 1, 1); PG8_SCHED; PG8_LDA(At, 1, 0); PG8_STAGE(PG8_SA(0, 1), a2 + hstep, voffA);
            PG8_WAIT_V(8); PG8_WAIT_L(0); PG8_BAR; PG8_MMA(0, 0, At, B0); PG8_MMA(0, 1, At, B1); PG8_BAR; PG8_SCHED;
            PG8_LDA(At, 1, 1); PG8_STAGE(PG8_SB(1, 0), b3, voffB); PG8_STAGE(PG8_SB(1, 1), b3 + hstep, voffB); PG8_STAGE(PG8_SA(1, 0), a3, voffA);
            PG8_WAIT_V(8); PG8_WAIT_L(0); PG8_BAR; PG8_MMA(1, 0, At, B0); PG8_MMA(1, 1, At, B1); PG8_BAR; PG8_SCHED;
            } else {
            PG8_LDB(B0, 0, 0); PG8_SCHED; PG8_LDA(At, 0, 0); PG8_STAGE(PG8_SA(1, 1), a1 + hstep, voffA);
            PG8_WAIT_L(8); PG8_BAR; PG8_WAIT_L(0); PG8_MMA(0, 0, At, B0); PG8_BAR; PG8_SCHED;
            PG8_LDB(B1, 0, 1); PG8_STAGE(PG8_SB(0, 0), b2, voffB);
            PG8_BAR; PG8_WAIT_L(0); PG8_MMA(0, 1, At, B1); PG8_BAR;
            PG8_LDA(At, 0, 1); PG8_STAGE(PG8_SA(0, 0), a2, voffA);
            PG8_BAR; PG8_WAIT_L(0); PG8_MMA(1, 0, At, B0); PG8_BAR; PG8_SCHED;
            PG8_STAGE(PG8_SB(0, 1), b2 + hstep, voffB);
            PG8_WAIT_V(6); PG8_BAR; PG8_MMA(1, 1, At, B1); PG8_BAR;
            PG8_LDB(B0, 1, 0); PG8_SCHED; PG8_LDA(At, 1, 0); PG8_STAGE(PG8_SA(0, 1), a2 + hstep, voffA);
            PG8_WAIT_L(8); PG8_BAR; PG8_WAIT_L(0); PG8_MMA(0, 0, At, B0); PG8_BAR; PG8_SCHED;
            PG8_LDB(B1, 1, 1); PG8_STAGE(PG8_SB(1, 0), b3, voffB);
            PG8_BAR; PG8_WAIT_L(0); PG8_MMA(0, 1, At, B1); PG8_BAR;
            PG8_LDA(At, 1, 1); PG8_STAGE(PG8_SA(1, 0), a3, voffA);
            PG8_BAR; PG8_WAIT_L(0); PG8_MMA(1, 0, At, B0); PG8_BAR; PG8_SCHED;
            PG8_STAGE(PG8_SB(1, 1), b3 + hstep, voffB);
            PG8_WAIT_V(6); PG8_BAR; PG8_MMA(1, 1, At, B1); PG8_BAR;
            }
        }
        if (Epi::HAS_MID && kh == 0) E.mid(acc, cur, wr, wc, fr, fq);
        }
        if constexpr (ALIGN_EPI) { if (wr == 0) PG8_BAR; }
        E(acc, cur, wr, wc, fr, fq, pf);
        if (!has_next) break;
        if constexpr (Epi::ACC_INIT) E.init(acc, nxt, wr, wc, fr, fq);
        else {
#pragma unroll
        for (int a = 0; a < 2; ++a)
#pragma unroll
            for (int b = 0; b < 2; ++b)
#pragma unroll
                for (int m = 0; m < 4; ++m)
#pragma unroll
                    for (int n = 0; n < 2; ++n) acc[a][b][m][n] = (f32x4){0.f, 0.f, 0.f, 0.f};
        }
        cur = nxt; cA = nA; cB = nB; ++ui;
        if constexpr (ALIGN_EPI) { if (wr == 1) PG8_BAR; }
    }
    PG8_WAIT_V(0);
    if constexpr (!ALIGN_EPI) { if (wr == 0) PG8_BAR; }
    PG8_BAR;
#undef PG8_SA
#undef PG8_SB
#undef PG8_STAGE
#undef PG8_LDA
#undef PG8_LDB
#undef PG8_MMA
#undef PG8_WAIT_V
#undef PG8_WAIT_L
#undef PG8_BAR
#undef PG8_SCHED
}
}

constexpr int NWAVES = 8;
constexpr int S = 16384, D = 1024, DC = 512, NIN = 4608, FF0 = 2816, FFE = 3584, NE = 8;
constexpr int MAXP = 136;
constexpr float RMS_EPS = 1e-6f, LNC_EPS = 1e-5f;

constexpr size_t MiB = 1u << 20;
constexpr size_t WS_CTL = 0, CTL_ZERO_BYTES = 32 * 1024;
constexpr size_t WS_SS = 1 * MiB;
constexpr size_t WS_TOKE = 2 * MiB, WS_TOKW = WS_TOKE + 64 * 1024, WS_TOKR = WS_TOKW + 128 * 1024, WS_TOKS = WS_TOKR + 64 * 1024, WS_CNT = WS_TOKS + 128 * 1024, WS_PS = WS_CNT + 8 * 1024;
constexpr size_t WS_SLOTR = 3 * MiB, WS_SLOTW = WS_SLOTR + 256 * 1024;
constexpr size_t WS_WM13 = 68 * MiB, WS_WM2 = 124 * MiB;
constexpr size_t WS_WL1 = 152 * MiB, WS_WL0 = 165 * MiB;
constexpr size_t WO_IN = 0, WO_AB = 9 * MiB, WO_O = 11 * MiB, WO_13 = 13 * MiB, WO_2 = 24 * MiB;
constexpr size_t WS_XB = 4 * MiB;
constexpr size_t WS_MG = 36 * MiB;
constexpr size_t WS_POOL = 195 * MiB;
constexpr size_t PO_A = 0, PO_V = 16 * MiB, PO_SB = 32 * MiB, PO_R = 48 * MiB, PO_G = 80 * MiB, PO_A2 = 112 * MiB, PO_HID = 144 * MiB, PO_A1 = 232 * MiB, PO_V1 = 248 * MiB;
constexpr size_t WS_XG = 152 * MiB;
constexpr size_t WS_Y = 186 * MiB;
constexpr size_t WS_HC = 254 * MiB;
constexpr size_t WS_PT = 373 * MiB;
constexpr size_t WS_END = 459 * MiB;
static_assert(WS_XG + (size_t)MAXP * 256 * D <= WS_Y && WS_Y + (size_t)MAXP * 256 * D * 2 <= WS_HC && WS_HC + (size_t)MAXP * 256 * FFE <= WS_END && WS_POOL + PO_HID + (size_t)S * FF0 * 2 <= WS_POOL + PO_A1 && WS_POOL + PO_V1 + 16 * MiB <= WS_END && WS_POOL + PO_A2 + 32 * MiB <= WS_POOL + PO_HID, "d_ws map");
static_assert(WS_XB + (size_t)S * D * 2 <= WS_MG && WS_MG + (size_t)S * D * 2 <= WS_WM13 && WS_WL0 + WO_2 + (size_t)D * FF0 * 2 <= WS_POOL && WS_WM2 + (size_t)NE * D * FFE <= WS_WL1 && WS_WM13 + (size_t)NE * 2 * FFE * D <= WS_WM2 && WS_WL1 + 13 * MiB <= WS_WL0, "weight map");
constexpr int CW_BAR = 4096;
constexpr int CW_XID = 1024;
constexpr int CW_TEAM = 2048;
static_assert((CW_BAR + 3456) * 4 <= (int)CTL_ZERO_BYTES && CW_TEAM + 64 * 16 <= CW_BAR, "barrier words inside the per-call memset");

constexpr int RING_OFF = 0, RING_BYTES = 131072;
constexpr int LDSCTL_OFF = RING_BYTES, MISC_OFF = LDSCTL_OFF + 320;
constexpr int LDS_BYTES = 147456;

#define GAS __attribute__((address_space(1)))
#define LAS __attribute__((address_space(3)))
typedef unsigned short bf16;
typedef unsigned v4u __attribute__((ext_vector_type(4)));
typedef unsigned v2u __attribute__((ext_vector_type(2)));
typedef int v4i __attribute__((ext_vector_type(4)));
typedef int v2i __attribute__((ext_vector_type(2)));
typedef float f32x4 __attribute__((ext_vector_type(4)));
typedef float f32x2 __attribute__((ext_vector_type(2)));
#define LDS_WAIT() asm volatile("s_waitcnt lgkmcnt(0)" ::: "memory")
#define VM_WAIT() asm volatile("s_waitcnt vmcnt(0)" ::: "memory")
using pg8::cvt_pk_bf16; using pg8::bflo; using pg8::bfhi; using pg8::sigmoid_f;

#define XB_TMO      128
#define XB_XCNT(j)  (256  + 64 * (j))
#define XB_XSUB(j)  (1280 + 64 * (j))
#define XB_XGEN(j)  (2304 + 64 * (j))
#define XB_TOP      3328
#define XB_TOPGEN   3392
#define XCD_BAR_WORDS 3456
#define XB_SPIN_CAP (1u << 18)

__device__ __forceinline__ unsigned xb_ld(unsigned* p)              { return __hip_atomic_load(p, __ATOMIC_RELAXED, __HIP_MEMORY_SCOPE_AGENT); }
__device__ __forceinline__ unsigned xb_add(unsigned* p, unsigned v) { return __hip_atomic_fetch_add(p, v, __ATOMIC_RELAXED, __HIP_MEMORY_SCOPE_AGENT); }
__device__ __forceinline__ unsigned xb_xcc_id() { return (unsigned)__builtin_amdgcn_s_getreg((3 << 11) | 20) & 0xFu; }
#define XB_SPIN(cond, bar) do { unsigned _sp = 0; while (cond) { __builtin_amdgcn_s_sleep(1); \
    if ((++_sp & 255u) == 0u) { if (xb_ld(&(bar)[XB_TMO])) break; if (_sp > XB_SPIN_CAP) { atomicAdd(&(bar)[XB_TMO], 1u); break; } } } } while (0)

struct XcdBarrier {
    unsigned* bar; unsigned x;
    volatile LAS unsigned* st;
};
__device__ __forceinline__ XcdBarrier xcd_barrier_post(unsigned* bar, volatile LAS unsigned* st) {
    XcdBarrier b; b.bar = bar; b.x = xb_xcc_id(); b.st = st;
    if (threadIdx.x == 0) (void)xb_add(&bar[XB_XCNT(b.x)], 1u);
    return b;
}
__device__ __forceinline__ void xcd_barrier_complete(unsigned* bar, unsigned x, unsigned& nloc, unsigned& nx) {
    const unsigned G = gridDim.x * gridDim.y * gridDim.z;
    unsigned sum, cnt, mine, sp = 0u;
    for (;;) {
        sum = 0u; cnt = 0u; mine = 0u;
#pragma unroll
        for (unsigned j = 0; j < 16; ++j) { const unsigned c = xb_ld(&bar[XB_XCNT(j)]); sum += c; cnt += (c > 0u) ? 1u : 0u; mine = (j == x) ? c : mine; }
        if (sum == G) break;
        __builtin_amdgcn_s_sleep(1);
        if ((++sp & 255u) == 0u) { if (xb_ld(&bar[XB_TMO])) break; if (sp > XB_SPIN_CAP) { atomicAdd(&bar[XB_TMO], 1u); break; } }
    }
    nloc = mine > 0u ? mine : 1u; nx = cnt > 0u ? cnt : 1u;
}
__device__ __forceinline__ void xcd_barrier(const XcdBarrier& b) {
    asm volatile("s_waitcnt vmcnt(0)" ::: "memory");
    __syncthreads();
    if (threadIdx.x == 0) {
        unsigned* bar = b.bar;
        __builtin_amdgcn_s_waitcnt(0);
        unsigned nloc = b.st[0], nx = b.st[1];
        if (nloc == 0u) { xcd_barrier_complete(bar, b.x, nloc, nx); b.st[0] = nloc; b.st[1] = nx; }
        const unsigned old = xb_add(&bar[XB_XSUB(b.x)], 1u);
        const unsigned gen = old / nloc;
        if (old + 1u == (gen + 1u) * nloc) {
            __builtin_amdgcn_fence(__ATOMIC_RELEASE, "agent");
            asm volatile("s_waitcnt vmcnt(0)" ::: "memory");
            const unsigned og = xb_add(&bar[XB_TOP], 1u);
            const unsigned tg = og / nx;
            if (og + 1u == (tg + 1u) * nx) xb_add(&bar[XB_TOPGEN], 1u);
            else XB_SPIN(xb_ld(&bar[XB_TOPGEN]) == tg, bar);
            __builtin_amdgcn_fence(__ATOMIC_ACQUIRE, "agent");
            xb_add(&bar[XB_XGEN(b.x)], 1u);
            asm volatile("s_waitcnt vmcnt(0)" ::: "memory");
        } else {
            XB_SPIN(xb_ld(&bar[XB_XGEN(b.x)]) == gen, bar);
            __builtin_amdgcn_fence(__ATOMIC_ACQUIRE, "agent");
            asm volatile("s_waitcnt vmcnt(0)" ::: "memory");
        }
    }
    __syncthreads();
}

__device__ __forceinline__ void team_barrier(unsigned* cnt, unsigned target, bool coloc, unsigned* tmo_bar) {
    asm volatile("s_waitcnt vmcnt(0)" ::: "memory");
    __syncthreads();
    if (threadIdx.x == 0) {
        __builtin_amdgcn_s_waitcnt(0);
        if (!coloc) { __builtin_amdgcn_fence(__ATOMIC_RELEASE, "agent"); asm volatile("s_waitcnt vmcnt(0)" ::: "memory"); }
        (void)xb_add(cnt, 1u);
        XB_SPIN(xb_ld(cnt) < target, tmo_bar);
        __builtin_amdgcn_fence(__ATOMIC_ACQUIRE, "agent");
        asm volatile("s_waitcnt vmcnt(0)" ::: "memory");
    }
    __syncthreads();
}

__device__ __forceinline__ float wave_sum(float v) {
#pragma unroll
    for (int o = 1; o < 64; o <<= 1) v += __shfl_xor(v, o);
    return v;
}
template <bool F8> __device__ __forceinline__ void tr_load(const float* src, int spitch, int scol0, const float* scale, float sc0, int k0, int lane, unsigned (&pa)[F8 ? 16 : 32], unsigned (&pb)[F8 ? 16 : 32]) {
    const int h = lane >> 5, c = lane & 31;
    const float* s = src + (size_t)(k0 + h) * spitch + scol0 + 4 * c;
    f32x4 x[32];
#pragma unroll
    for (int i = 0; i < 32; ++i) x[i] = __builtin_nontemporal_load((const f32x4*)(s + (size_t)(2 * i) * spitch));
#pragma unroll
    for (int i = 0; i < 32; i += 2) {
        float ea[2], oa[2], eb[2], ob[2];
#pragma unroll
        for (int d = 0; d < 2; ++d) {
            const float sk = scale ? scale[k0 + 2 * (i + d) + h] * sc0 : sc0;
            const f32x4 y = x[i + d] * sk;
            auto r = __builtin_amdgcn_permlane32_swap(__float_as_uint(y.x), __float_as_uint(y.z), false, false); ea[d] = __uint_as_float(r[0]); oa[d] = __uint_as_float(r[1]);
            auto q = __builtin_amdgcn_permlane32_swap(__float_as_uint(y.y), __float_as_uint(y.w), false, false); eb[d] = __uint_as_float(q[0]); ob[d] = __uint_as_float(q[1]);
        }
        if (F8) { pa[i >> 1] = pg8::pk4_fp8(ea[0], oa[0], ea[1], oa[1]); pb[i >> 1] = pg8::pk4_fp8(eb[0], ob[0], eb[1], ob[1]); }
        else { pa[i] = cvt_pk_bf16(ea[0], oa[0]); pa[i + 1] = cvt_pk_bf16(ea[1], oa[1]); pb[i] = cvt_pk_bf16(eb[0], ob[0]); pb[i + 1] = cvt_pk_bf16(eb[1], ob[1]); }
    }
}
__device__ __forceinline__ void tr_item(const float* src, int spitch, int scol0, const float* scale, bf16* dst, int dpitch, int drow0, int dk0, int k0, int lane, LAS unsigned char* tile) {
    unsigned pa[32], pb[32];
    tr_load<false>(src, spitch, scol0, scale, 1.0f, k0, lane, pa, pb);
    const int ra = 4 * (lane & 31) + 2 * (lane >> 5), sa = (ra >> 1) & 7;
#pragma unroll
    for (int j = 0; j < 8; ++j) {
        *(LAS v4u*)(tile + ra * 128 + ((j ^ sa) << 4)) = (v4u){pa[4 * j], pa[4 * j + 1], pa[4 * j + 2], pa[4 * j + 3]};
        *(LAS v4u*)(tile + (ra + 1) * 128 + ((j ^ sa) << 4)) = (v4u){pb[4 * j], pb[4 * j + 1], pb[4 * j + 2], pb[4 * j + 3]};
    }
#pragma unroll
    for (int jj = 0; jj < 16; ++jj) { const int r = (lane >> 3) + 8 * jj, pc = lane & 7, ch = pc ^ ((r >> 1) & 7);
        const v4u v = *(const LAS v4u*)(tile + r * 128 + (pc << 4));
        *(v4u*)(dst + (size_t)(drow0 + r) * dpitch + dk0 + k0 + 8 * ch) = v; }
}
template <int HALF> __device__ __forceinline__ void tr_item_f8(const float* src, int spitch, int scol0, const float* scale, unsigned char* dst, int dpitch, int drow0, int k0, int lane, LAS unsigned char* tile) {
    const int ra = 4 * (lane & 31) + 2 * (lane >> 5), sa = (ra >> 1) & 7;
#pragma unroll 1
    for (int hf = (HALF < 0 ? 0 : HALF); hf < (HALF < 0 ? 2 : HALF + 1); ++hf) {
        unsigned pa[16], pb[16];
        tr_load<true>(src, spitch, scol0, scale, pg8::F8_WSCALE, k0 + 64 * hf, lane, pa, pb);
#pragma unroll
        for (int j = 0; j < 4; ++j) {
            *(LAS v4u*)(tile + ra * 128 + (((4 * hf + j) ^ sa) << 4)) = (v4u){pa[4 * j], pa[4 * j + 1], pa[4 * j + 2], pa[4 * j + 3]};
            *(LAS v4u*)(tile + (ra + 1) * 128 + (((4 * hf + j) ^ sa) << 4)) = (v4u){pb[4 * j], pb[4 * j + 1], pb[4 * j + 2], pb[4 * j + 3]};
        }
    }
    if (HALF < 0) {
#pragma unroll
        for (int jj = 0; jj < 16; ++jj) { const int r = (lane >> 3) + 8 * jj, pc = lane & 7, ch = pc ^ ((r >> 1) & 7);
            const v4u v = *(const LAS v4u*)(tile + r * 128 + (pc << 4));
            *(v4u*)(dst + (size_t)(drow0 + r) * dpitch + k0 + 16 * ch) = v; }
    } else {
#pragma unroll
        for (int jj = 0; jj < 8; ++jj) { const int r = (lane >> 2) + 16 * jj, ch = 4 * HALF + (lane & 3), pc = ch ^ ((r >> 1) & 7);
            const v4u v = *(const LAS v4u*)(tile + r * 128 + (pc << 4));
            *(v4u*)(dst + (size_t)(drow0 + r) * dpitch + k0 + 16 * ch) = v; }
    }
}

struct Args { const float* in[31]; float* out; unsigned char* ws; int ph_lo, ph_hi; };

constexpr int I_IN = 36 * 16, I_A = 8 * 8, I_O = 8 * 16, I_MIX = I_IN + 2 * I_A + I_O, I_13 = 44 * 16, I_2 = 8 * 44, I_M13 = 56 * 8, I_M2 = 8 * 28;
__device__ __forceinline__ void wt_item(const Args& a, int it, int lane, LAS unsigned char* tile) {
    unsigned char* ws = a.ws;
    int r = it;
    if (r < 2 * I_MIX) {
        const int L = r / I_MIX; r -= L * I_MIX;
        unsigned char* wl = ws + (L ? WS_WL1 : WS_WL0);
        if (r < I_IN) {
            const int kb = r / 36, nb = r % 36, u = nb >> 1, bj = nb & 1;
            int col0;
            if (u < 4) col0 = (bj ? 512 : 0) + 128 * u;
            else if (u < 8) col0 = (bj ? 2048 : 1536) + 128 * (u - 4);
            else if (u < 10) col0 = 1024 + 256 * (u - 8) + 128 * bj;
            else col0 = (bj ? 3584 : 2560) + 128 * (u - 10);
            tr_item(L ? a.in[16] : a.in[2], NIN, col0, L ? a.in[15] : a.in[1], (bf16*)(wl + WO_IN), D, nb * 128, 0, kb * 64, lane, tile);
        } else if (r < I_IN + I_A) { r -= I_IN; const int kb = r / 8, nb = r % 8;
            tr_item(L ? a.in[21] : a.in[7], D, nb * 128, nullptr, (bf16*)(wl + WO_AB), D, nb * 128, 0, kb * 64, lane, tile);
        } else if (r < I_IN + 2 * I_A) { r -= I_IN + I_A; const int kb = r / 8, nb = r % 8;
            tr_item(L ? a.in[23] : a.in[9], D, nb * 128, nullptr, (bf16*)(wl + WO_AB), D, nb * 128, DC, kb * 64, lane, tile);
        } else { r -= I_IN + 2 * I_A; const int kb = r / 8, nb = r % 8;
            tr_item(L ? a.in[24] : a.in[10], D, nb * 128, nullptr, (bf16*)(wl + WO_O), D, nb * 128, 0, kb * 64, lane, tile);
        }
        return;
    }
    r -= 2 * I_MIX;
    if (r < I_13) {
        const int kb = r / 44, nb = r % 44, u = nb >> 1, bj = nb & 1;
        tr_item(bj ? a.in[13] : a.in[12], FF0, 128 * u, a.in[11], (bf16*)(ws + WS_WL0 + WO_13), D, nb * 128, 0, kb * 64, lane, tile);
        return;
    }
    r -= I_13;
    if (r < I_2) { const int kb = r / 8, nb = r % 8;
        tr_item(a.in[14], D, nb * 128, nullptr, (bf16*)(ws + WS_WL0 + WO_2), FF0, nb * 128, 0, kb * 64, lane, tile);
        return;
    }
}
constexpr int N_MOE_ITEMS = NE * (I_M13 + I_M2), N_DENSE_ITEMS = 2 * I_MIX + I_13 + I_2;
constexpr int SLOT_Q = 2, SLOT_EXTRA_WGS = 0, N_SLOT_ITEMS = 512 * SLOT_Q + SLOT_EXTRA_WGS * 4;
constexpr int N_MOE_P0 = N_MOE_ITEMS - 3 * N_SLOT_ITEMS;
template <int HALF> __device__ __forceinline__ void moe_item(const Args& a, int r, int lane, LAS unsigned char* tile) {
    unsigned char* ws = a.ws;
    if (r < NE * I_M13) {
        const int e = r / I_M13; r -= e * I_M13;
        const int kb = r / 56, nb = r % 56, u = nb >> 1, bj = nb & 1;
        tr_item_f8<HALF>((bj ? a.in[28] : a.in[27]) + (size_t)e * D * FFE, FFE, 128 * u, a.in[25], ws + WS_WM13 + (size_t)e * 2 * FFE * D, D, nb * 128, kb * 128, lane, tile);
        return;
    }
    r -= NE * I_M13;
    { const int e = r / I_M2; r -= e * I_M2; const int kb = r / 8, nb = r % 8;
      tr_item_f8<HALF>(a.in[29] + (size_t)e * FFE * D, D, nb * 128, nullptr, ws + WS_WM2 + (size_t)e * D * FFE, FFE, nb * 128, kb * 128, lane, tile); }
}
#define MOE_SLOT(s) do { if (G == 256 && bid >= 128) { \
        for (int q_ = 0; q_ < SLOT_Q + ((bid >= 256 - SLOT_EXTRA_WGS) ? 1 : 0); ++q_) { \
            const int it_ = N_MOE_P0 + (s) * N_SLOT_ITEMS + (q_ < SLOT_Q ? q_ * 512 + (bid - 128) * (NWAVES / 2) : SLOT_Q * 512 + (bid - (256 - SLOT_EXTRA_WGS)) * (NWAVES / 2)) + (wave >> 1); \
            if (wave & 1) moe_item<1>(args, it_, lane, lds + RING_OFF + wave * 16384); else moe_item<0>(args, it_, lane, lds + RING_OFF + wave * 16384); } } } while (0)

__global__ void __launch_bounds__(NWAVES * 64, 2) fwd(Args args) {
    extern __shared__ __attribute__((aligned(16))) unsigned char lds_raw[];
    LAS unsigned char* lds = (LAS unsigned char*)lds_raw;
    volatile LAS unsigned* MISC = (volatile LAS unsigned*)(lds + MISC_OFF);
    const int tid = threadIdx.x, lane = tid & 63, wave = __builtin_amdgcn_readfirstlane(tid >> 6);
    const int G = gridDim.x; const int vcu = (G % 8 == 0) ? ((int)blockIdx.x % 8) * (G / 8) + (int)blockIdx.x / 8 : (int)blockIdx.x;
    unsigned char* const ws = args.ws;
    unsigned* const ctl = (unsigned*)(ws + WS_CTL);
    for (int u = tid; u < (LDS_BYTES - LDSCTL_OFF) / 4; u += NWAVES * 64) ((LAS unsigned*)(lds + LDSCTL_OFF))[u] = 0u;
    __syncthreads();
    XcdBarrier bar; bar.bar = ctl + CW_BAR; bar.x = 0; bar.st = nullptr;
    if (!MK_PER_PHASE) bar = xcd_barrier_post(ctl + CW_BAR, MISC + 8);
    if (!MK_PER_PHASE && threadIdx.x == 0) __hip_atomic_store(ctl + CW_XID + blockIdx.x, bar.x + 1u, __ATOMIC_RELAXED, __HIP_MEMORY_SCOPE_AGENT);
    const int lo = args.ph_lo, hi = args.ph_hi;
#ifndef PH_MASK
#define PH_MASK 0xFFFFu
#endif
#define IN(k) (((PH_MASK >> (k)) & 1u) && lo <= (k) && (k) < hi)
#ifndef REP_MASK
#define REP_MASK 0u
#endif
#define REPS(k) (1 + (int)((REP_MASK >> (k)) & 1u))
#define SEAM(k) do { if (IN((k) + 1)) { if (MK_PER_PHASE) { if (tid == 0) __hip_atomic_store(ctl + 0, 0xBADBA0u, __ATOMIC_RELAXED, __HIP_MEMORY_SCOPE_AGENT); } else xcd_barrier(bar); } } while (0)
#define TEAM_CHECK() do { if (!MK_PER_PHASE && threadIdx.x == 0) { unsigned ok_ = 1u; for (int j_ = 0; j_ < 4; ++j_) ok_ &= (xb_ld(ctl + CW_XID + ((int)blockIdx.x & 63) + 64 * j_) == bar.x + 1u) ? 1u : 0u; MISC[12] = ok_; } } while (0)
#define TEAM_SEAM(k, seq) do { if (IN((k) + 1)) { if (!MK_PER_PHASE && G == 256) team_barrier(ctl + CW_TEAM + 16 * (8 * ((int)blockIdx.x & 7) + (((int)blockIdx.x >> 3) & 7)), 4u * ((unsigned)(seq) + 1u), MISC[12] != 0u, ctl + CW_BAR); else SEAM(k); } } while (0)
    const int gw = vcu * NWAVES + wave, NGW = G * NWAVES;
    const int vr = (G == 256) ? 4 * (8 * ((int)blockIdx.x & 7) + (((int)blockIdx.x >> 3) & 7)) + ((int)blockIdx.x >> 6) : vcu;
#define PHASE_PTRS() GAS unsigned char* wsp = (GAS unsigned char*)ws; asm volatile("" : "+s"(wsp)); int bid = (int)blockIdx.x; asm volatile("" : "+s"(bid)); (void)bid; int tidp_ = (int)threadIdx.x; asm volatile("" : "+v"(tidp_)); const int tid = tidp_, lane = tid & 63; (void)tid; (void)lane; float* const ssb = (float*)(wsp + WS_SS); bf16* const XB = (bf16*)(wsp + WS_XB); \
    GAS unsigned char* const pool = wsp + WS_POOL; (void)ssb; (void)XB; (void)pool

#define RSTD_TABLE(pa) do { LAS float* rt_ = (LAS float*)(lds + LDSCTL_OFF + 1024); if (tid < 256) { const f32x4* p_ = (const f32x4*)(ssb + ((size_t)(pa) * 256 + tid) * 16); \
        const f32x4 a_ = p_[0], b_ = p_[1], c_ = p_[2], d_ = p_[3]; const float s_ = (((a_.x + a_.y) + (a_.z + a_.w)) + ((b_.x + b_.y) + (b_.z + b_.w))) + (((c_.x + c_.y) + (c_.z + c_.w)) + ((d_.x + d_.y) + (d_.z + d_.w))); \
        rt_[tid] = __builtin_amdgcn_rsqf(s_ * (1.0f / 1024.0f) + 1e-6f); } __syncthreads(); } while (0)
    const LAS float* const RTAB = (const LAS float*)(lds + LDSCTL_OFF + 1024);

    if (IN(0)) {
        PHASE_PTRS();
        for (int rep_ = 0; rep_ < REPS(0); ++rep_)
        if (G == 256 && N_MOE_P0 >= 2048 && N_MOE_P0 <= 2304) {
            LAS unsigned char* const til = lds + RING_OFF + wave * 16384;
#pragma unroll 1
            for (int st = 0; st < 3; ++st) {
                int kind = 0, idx = 0;
                if (st == 0) { kind = 1; idx = wave * 256 + bid; }
                else if (wave == 0) { kind = (st == 1 && 2048 + bid < N_MOE_P0) ? 1 : 0; idx = 2048 + bid; }
                else { const int d = (wave - 1) * 256 + bid; if (st == 1) { kind = 2; idx = d; } else { kind = (1792 + d < N_DENSE_ITEMS) ? 2 : 0; idx = 1792 + d; } }
                if (kind == 1) moe_item<-1>(args, idx, lane, til); else if (kind == 2) wt_item(args, idx, lane, til);
            }
        } else
        for (int it = gw; it < N_DENSE_ITEMS + N_MOE_P0; it += NGW) { if (it < N_DENSE_ITEMS) wt_item(args, it, lane, lds + RING_OFF + wave * 16384); else moe_item<-1>(args, it - N_DENSE_ITEMS, lane, lds + RING_OFF + wave * 16384); }
        const float* x = args.in[0];
        for (int m0 = gw; m0 < S; m0 += 4 * NGW) {
            f32x4 v[4][4];
#pragma unroll
            for (int b = 0; b < 4; ++b) { const f32x4* xr = (const f32x4*)(x + (size_t)(m0 + b * NGW) * D) + lane;
#pragma unroll
                for (int j = 0; j < 4; ++j) v[b][j] = __builtin_nontemporal_load(xr + 64 * j); }
#pragma unroll
            for (int b = 0; b < 4; ++b) {
                const int m = m0 + b * NGW; float s = 0.f;
#pragma unroll
                for (int j = 0; j < 4; ++j) s += (v[b][j].x * v[b][j].x + v[b][j].y * v[b][j].y) + (v[b][j].z * v[b][j].z + v[b][j].w * v[b][j].w);
                s = wave_sum(s);
                v2u* o8 = (v2u*)(XB + (size_t)m * D) + lane;
#pragma unroll
                for (int j = 0; j < 4; ++j) { v2u w; w.x = cvt_pk_bf16(v[b][j].x, v[b][j].y); w.y = cvt_pk_bf16(v[b][j].z, v[b][j].w); o8[64 * j] = w; }
                if (lane < 16) ssb[(size_t)m * 16 + lane] = (lane == 0) ? s : 0.f;
            }
        }
        SEAM(0);
    }

    for (int layer = 0; layer < 2; ++layer) {
        const int pb = 1 + 6 * layer;
        if (IN(pb)) {
            PHASE_PTRS(); GAS unsigned char* const wl = wsp + (layer ? WS_WL1 : WS_WL0); (void)wl;
            pg8::Gemm g{XB, (const bf16*)(wl + WO_IN), D, D};
            int pa0; { pg8::StaticOrder S0; S0.init(S / 256, 10, G, bid, 0); pg8::Unit u0; pa0 = S0.next(0, u0) ? u0.pa : 0; }
            if (layer == 0) TEAM_CHECK();
            RSTD_TABLE(pa0);
            for (int rep_ = 0; rep_ < REPS(1); ++rep_)
            { pg8::StaticOrder So; So.init(S / 256, 10, G, bid, 0);
              pg8::EpiG1<0> E{ssb, (bf16*)(pool + (layer ? PO_A1 : PO_A)), (bf16*)(pool + (layer ? PO_V1 : PO_V)), (bf16*)(pool + PO_SB), (bf16*)(pool + PO_R), (bf16*)(pool + PO_G), RTAB, pa0};
              pg8::gemm_phase<pg8::EpiG1<0>, pg8::StaticOrder, true, true>(lds + RING_OFF, g, So, E); }
            for (int rep_ = 0; rep_ < REPS(20); ++rep_)
            { pg8::StaticOrder So; So.init(S / 256, 8, G, bid, 10);
              pg8::EpiG1<1> E{ssb, (bf16*)(pool + (layer ? PO_A1 : PO_A)), (bf16*)(pool + (layer ? PO_V1 : PO_V)), (bf16*)(pool + PO_SB), (bf16*)(pool + PO_R), (bf16*)(pool + PO_G), RTAB, pa0};
              pg8::gemm_phase<pg8::EpiG1<1>, pg8::StaticOrder, true, true>(lds + RING_OFF, g, So, E); }
            if (layer == 0) MOE_SLOT(0); else MOE_SLOT(2);
            SEAM(pb);
        }
        if (IN(pb + 1)) {
            PHASE_PTRS(); GAS unsigned char* const wl = wsp + (layer ? WS_WL1 : WS_WL0); (void)wl;
            const float* conv_a = layer ? args.in[17] : args.in[3]; const float* conv_ab = layer ? args.in[18] : args.in[4];
            const float* ln_g = layer ? args.in[19] : args.in[5]; const float* ln_b = layer ? args.in[20] : args.in[6]; const float* conv_b = layer ? args.in[22] : args.in[8];
            const bf16* abuf = (const bf16*)(pool + (layer ? PO_A1 : PO_A)); const bf16* vbuf = (const bf16*)(pool + (layer ? PO_V1 : PO_V)); const bf16* sbuf = (const bf16*)(pool + PO_SB); bf16* A2 = (bf16*)(pool + PO_A2);
            LAS float* cv = (LAS float*)(lds + RING_OFF);
            LAS float* wl31 = (LAS float*)(lds + RING_OFF + 65536);
            const int cq = tid & 127, oct = tid >> 7;
            for (int idx = tid; idx < 31 * DC / 4; idx += NWAVES * 64) ((LAS f32x4*)wl31)[idx] = ((const f32x4*)conv_a)[idx];
            f32x4 wb[3];
#pragma unroll
            for (int j = 0; j < 3; ++j) wb[j] = *(const f32x4*)(conv_b + j * DC + 4 * cq);
            const f32x4 cbias = *(const f32x4*)(conv_ab + 4 * cq);
            const f32x4 g0 = *(const f32x4*)(ln_g + 4 * lane), g1 = *(const f32x4*)(ln_g + 256 + 4 * lane), b0 = *(const f32x4*)(ln_b + 4 * lane), b1 = *(const f32x4*)(ln_b + 256 + 4 * lane);
            __syncthreads();
            int ctile0 = vcu, cstep = G;
            if (G == 256) { ctile0 = 8 * (8 * (bid & 7) + ((bid >> 3) & 7)) + 2 * (bid >> 6); cstep = 1; }
            for (int rep_ = 0; rep_ < REPS(2); ++rep_)
            for (int tile = ctile0, tcount = 0; (G == 256) ? (tcount < 2) : (tile < S / 32); tile += cstep, ++tcount) {
                const int tb = tile * 32 + oct * 8;
                {
                    v2u in[38];
#pragma unroll
                    for (int i = 0; i < 38; ++i) { const int r = tb - 30 + i; in[i] = (r >= 0) ? *(const v2u*)(abuf + (size_t)r * DC + 4 * cq) : (v2u){0u, 0u}; }
                    v2u vin[10], sv[8];
#pragma unroll
                    for (int i = 0; i < 10; ++i) { const int r = tb - 2 + i; vin[i] = (r >= 0) ? *(const v2u*)(vbuf + (size_t)r * DC + 4 * cq) : (v2u){0u, 0u}; }
#pragma unroll
                    for (int o = 0; o < 8; ++o) sv[o] = *(const v2u*)(sbuf + (size_t)(tb + o) * DC + 4 * cq);
                    f32x4 acc8[8];
#pragma unroll
                    for (int o = 0; o < 8; ++o) acc8[o] = cbias;
#pragma unroll
                    for (int j = 0; j < 31; ++j) { const f32x4 w = *(const LAS f32x4*)(wl31 + j * DC + 4 * cq);
#pragma unroll
                        for (int o = 0; o < 8; ++o) { const v2u x = in[o + j]; acc8[o] += (f32x4){bflo(x.x), bfhi(x.x), bflo(x.y), bfhi(x.y)} * w; } }
#pragma unroll
                    for (int o = 0; o < 8; ++o) *(LAS f32x4*)(cv + (oct * 8 + o) * DC + 4 * cq) = acc8[o];
#pragma unroll
                    for (int o = 0; o < 8; ++o) {
                        f32x4 u = (f32x4){0.f, 0.f, 0.f, 0.f};
#pragma unroll
                        for (int j = 0; j < 3; ++j) { const v2u x = vin[o + j]; u += (f32x4){bflo(x.x), bfhi(x.x), bflo(x.y), bfhi(x.y)} * wb[j]; }
                        const v2u s = sv[o]; v2u w; w.x = cvt_pk_bf16(bflo(s.x) * u.x, bfhi(s.x) * u.y); w.y = cvt_pk_bf16(bflo(s.y) * u.z, bfhi(s.y) * u.w);
                        *(v2u*)(A2 + (size_t)(tb + o) * D + DC + 4 * cq) = w;
                    }
                }
                __syncthreads();
#pragma unroll
                for (int tk = 0; tk < 4; ++tk) {
                    const int t = wave * 4 + tk;
                    const f32x4 xa = *(const LAS f32x4*)(cv + t * DC + 4 * lane), xc = *(const LAS f32x4*)(cv + t * DC + 256 + 4 * lane);
                    const float mean = wave_sum((xa.x + xa.y) + (xa.z + xa.w) + (xc.x + xc.y) + (xc.z + xc.w)) * (1.f / DC);
                    const f32x4 da = xa - mean, dc = xc - mean;
                    const float var = wave_sum((da.x * da.x + da.y * da.y) + (da.z * da.z + da.w * da.w) + (dc.x * dc.x + dc.y * dc.y) + (dc.z * dc.z + dc.w * dc.w)) * (1.f / DC);
                    const float rstd = __builtin_amdgcn_rsqf(var + LNC_EPS);
                    f32x4 ya = da * rstd * g0 + b0, yc = dc * rstd * g1 + b1;
#pragma unroll
                    for (int j = 0; j < 4; ++j) { ya[j] = ya[j] * sigmoid_f(ya[j]); yc[j] = yc[j] * sigmoid_f(yc[j]); }
                    bf16* orow = A2 + (size_t)(tile * 32 + t) * D;
                    v2u w; w.x = cvt_pk_bf16(ya.x, ya.y); w.y = cvt_pk_bf16(ya.z, ya.w); *(v2u*)(orow + 4 * lane) = w;
                    w.x = cvt_pk_bf16(yc.x, yc.y); w.y = cvt_pk_bf16(yc.z, yc.w); *(v2u*)(orow + 256 + 4 * lane) = w;
                }
                __syncthreads();
            }
            TEAM_SEAM(pb + 1, layer ? 5 : 0);
        }
        if (IN(pb + 2)) {
            PHASE_PTRS(); GAS unsigned char* const wl = wsp + (layer ? WS_WL1 : WS_WL0); (void)wl;
            pg8::StaticOrder So; So.init(S / 256, D / 256, G, bid);
            pg8::Gemm g{(const bf16*)(pool + PO_A2), (const bf16*)(wl + WO_AB), D, D};
            pg8::EpiG2 E{(const bf16*)(pool + PO_R), (const bf16*)(pool + PO_G), (bf16*)(wsp + WS_MG)};
            for (int rep_ = 0; rep_ < REPS(3); ++rep_)
            pg8::gemm_phase<pg8::EpiG2, pg8::StaticOrder, true, true>(lds + RING_OFF, g, So, E);
            TEAM_SEAM(pb + 2, layer ? 6 : 1);
        }
        if (IN(pb + 3)) {
            PHASE_PTRS(); GAS unsigned char* const wl = wsp + (layer ? WS_WL1 : WS_WL0); (void)wl;
            pg8::Gemm g{(const bf16*)(wsp + WS_MG), (const bf16*)(wl + WO_O), D, D}; pg8::StaticOrder So; So.init(S / 256, D / 256, G, bid);
            if (layer == 0) { pg8::EpiRes<true, true> E{args.in[0], XB, ssb};
                pg8::gemm_phase<pg8::EpiRes<true, true>, pg8::StaticOrder, true, true>(lds + RING_OFF, g, So, E); }
            else { pg8::EpiRes<false, false> E{nullptr, XB, ssb};
                pg8::gemm_phase<pg8::EpiRes<false, false>, pg8::StaticOrder, true, true>(lds + RING_OFF, g, So, E); }
            TEAM_SEAM(pb + 3, layer ? 7 : 2);
        }
        if (layer == 0) {
            if (IN(5)) {
                PHASE_PTRS();
                pg8::Gemm g{XB, (const bf16*)(wsp + WS_WL0 + WO_13), D, D}; pg8::StaticOrder So; So.init(S / 256, 2 * FF0 / 256, G, bid);
                int pa0; { pg8::Unit u0; pa0 = So.next(0, u0) ? u0.pa : 0; }
                RSTD_TABLE(pa0);
                pg8::EpiUp<false> E{ssb, (bf16*)(pool + PO_HID), FF0, RTAB, pa0};
                for (int rep_ = 0; rep_ < REPS(5); ++rep_)
                pg8::gemm_phase<pg8::EpiUp<false>, pg8::StaticOrder, true, true>(lds + RING_OFF, g, So, E);
                MOE_SLOT(1);
                TEAM_SEAM(5, 3);
            }
            if (IN(6)) {
                PHASE_PTRS();
                pg8::Gemm g{(const bf16*)(pool + PO_HID), (const bf16*)(wsp + WS_WL0 + WO_2), FF0, FF0}; pg8::StaticOrder So; So.init(S / 256, D / 256, G, bid);
                pg8::EpiRes<true, false> E{nullptr, XB, ssb};
                pg8::gemm_phase<pg8::EpiRes<true, false>, pg8::StaticOrder, true, true>(lds + RING_OFF, g, So, E);
                TEAM_SEAM(6, 4);
            }
        }
    }

#define MOE_PTRS() PHASE_PTRS(); unsigned* const tok_e = (unsigned*)(wsp + WS_TOKE); f32x2* const tok_w = (f32x2*)(wsp + WS_TOKW); float* const tok_r = (float*)(wsp + WS_TOKR); v2i* const tok_s = (v2i*)(wsp + WS_TOKS); \
    int* const cntg = (int*)(wsp + WS_CNT); int* const psg = (int*)(wsp + WS_PS); float* const slot_r = (float*)(wsp + WS_SLOTR); float* const slot_w = (float*)(wsp + WS_SLOTW); \
    unsigned char* const XG = (unsigned char*)(wsp + WS_XG); unsigned char* const HC = (unsigned char*)(wsp + WS_HC); unsigned char* const Y = (unsigned char*)(wsp + WS_Y); (void)Y; unsigned char* const PT = (unsigned char*)(wsp + WS_PT); (void)PT; (void)tok_e; (void)tok_w; (void)tok_r; (void)tok_s; (void)cntg; (void)psg; (void)slot_r; (void)slot_w; (void)XG; (void)HC

    if (IN(11)) {
        MOE_PTRS();
        LAS float* rgA = (LAS float*)(lds + RING_OFF);
        LAS float* rgB = rgA + 4096;
        LAS int* hist = (LAS int*)(lds + RING_OFF + 32768);
        const float* router = args.in[26]; const float* g2 = args.in[25];
        v2u xrow[8][4];
#pragma unroll
        for (int b = 0; b < 8; ++b) { const v2u* xr_ = (const v2u*)(XB + (size_t)(vr * 64 + wave * 8 + b) * D) + lane;
#pragma unroll
            for (int j = 0; j < 4; ++j) xrow[b][j] = xr_[64 * j]; }
        { f32x4 rv[4]; float gk[4];
#pragma unroll
          for (int i4 = 0; i4 < 4; ++i4) { const int q = tid + 512 * i4; rv[i4] = ((const f32x4*)router)[q]; gk[i4] = g2[q >> 1]; }
#pragma unroll
          for (int i4 = 0; i4 < 4; ++i4) { const int q = tid + 512 * i4, k = q >> 1, jj = k >> 8, ln = (k & 255) >> 2, ii = k & 3;
              *(LAS f32x4*)(((q & 1) ? rgB : rgA) + ((jj * 4 + ii) * 64 + ln) * 4) = rv[i4] * gk[i4]; } }
        if (tid < 8) hist[tid] = 0;
        __syncthreads();
        float ac[8][8], sqv[8];
#pragma unroll
        for (int b = 0; b < 8; ++b) { sqv[b] = 0.f;
#pragma unroll
            for (int e = 0; e < 8; ++e) ac[b][e] = 0.f; }
#pragma unroll
        for (int j = 0; j < 4; ++j)
#pragma unroll
            for (int i = 0; i < 4; ++i) {
                const f32x4 ra = *(const LAS f32x4*)(rgA + ((j * 4 + i) * 64 + lane) * 4), rb = *(const LAS f32x4*)(rgB + ((j * 4 + i) * 64 + lane) * 4);
#pragma unroll
                for (int b = 0; b < 8; ++b) { const v2u xp = xrow[b][j]; const float xx = (i == 0) ? bflo(xp.x) : (i == 1) ? bfhi(xp.x) : (i == 2) ? bflo(xp.y) : bfhi(xp.y);
                    sqv[b] += xx * xx;
                    ac[b][0] += xx * ra.x; ac[b][1] += xx * ra.y; ac[b][2] += xx * ra.z; ac[b][3] += xx * ra.w; ac[b][4] += xx * rb.x; ac[b][5] += xx * rb.y; ac[b][6] += xx * rb.z; ac[b][7] += xx * rb.w; } }
#pragma unroll
        for (int b = 0; b < 8; ++b) {
            const int t = vr * 64 + wave * 8 + b;
            const float sq = wave_sum(sqv[b]);
            float lg[8];
#pragma unroll
            for (int e = 0; e < 8; ++e) lg[e] = wave_sum(ac[b][e]);
            const float rstd = __builtin_amdgcn_rsqf(sq * (1.f / D) + RMS_EPS);
            int e0 = 0; float l0 = lg[0];
#pragma unroll
            for (int e = 1; e < 8; ++e) if (lg[e] > l0) { l0 = lg[e]; e0 = e; }
            int e1 = -1; float l1 = 0.f;
#pragma unroll
            for (int e = 0; e < 8; ++e) if (e != e0 && (e1 < 0 || lg[e] > l1)) { l1 = lg[e]; e1 = e; }
            const float w0 = 1.0f / (1.0f + __expf((l1 - l0) * rstd)), w1 = 1.0f - w0;
            if (lane == 0) { tok_e[t] = (unsigned)e0 | ((unsigned)e1 << 8); tok_w[t] = (f32x2){w0, w1}; tok_r[t] = rstd; __hip_atomic_fetch_add(&hist[e0], 1, __ATOMIC_RELAXED, __HIP_MEMORY_SCOPE_WORKGROUP); __hip_atomic_fetch_add(&hist[e1], 1, __ATOMIC_RELAXED, __HIP_MEMORY_SCOPE_WORKGROUP); }
        }
        __syncthreads();
        if (tid < 8) cntg[vr * 8 + tid] = hist[tid];
        __syncthreads();
        SEAM(11);
    }
    if (IN(12)) {
        MOE_PTRS();
        LAS int* sh = (LAS int*)(lds + RING_OFF);
        v4u xr8[8][2];
#pragma unroll
        for (int tk = 0; tk < 8; ++tk) { const v4u* xr = (const v4u*)(XB + (size_t)(vr * 64 + wave * 8 + tk) * D) + 2 * lane; xr8[tk][0] = xr[0]; xr8[tk][1] = xr[1]; }
        {
            v4i c0 = (v4i){0, 0, 0, 0}, c1 = c0;
            if (tid < G) { c0 = *(const v4i*)(cntg + tid * 8); c1 = *(const v4i*)(cntg + tid * 8 + 4); }
            const int c[8] = {c0.x, c0.y, c0.z, c0.w, c1.x, c1.y, c1.z, c1.w};
#pragma unroll
            for (int e = 0; e < 8; ++e) { int a = c[e], b = (tid < vr) ? c[e] : 0;
#pragma unroll
                for (int o = 1; o < 64; o <<= 1) { a += __shfl_xor(a, o); b += __shfl_xor(b, o); }
                if (lane == 0) { sh[256 + wave * 16 + e] = a; sh[256 + wave * 16 + 8 + e] = b; } }
        }
        __syncthreads();
        if (tid == 0) { int p = 0;
            for (int e = 0; e < 8; ++e) { int T = 0, P = 0; for (int w = 0; w < NWAVES; ++w) { T += sh[256 + w * 16 + e]; P += sh[256 + w * 16 + 8 + e]; }
                sh[e] = T; sh[16 + e] = p; sh[32 + e] = 256 * p + P; p += (T + 255) >> 8; }
            sh[24] = p;
            if (vr == 0) { for (int e = 0; e < 9; ++e) psg[e] = sh[16 + e]; } }
        __syncthreads();
        if (wave == 0) {
            const int t = vr * 64 + lane; const unsigned ee = tok_e[t]; const int e0 = ee & 255, e1 = ee >> 8; int s0 = 0, s1 = 0;
            const unsigned long long below = (1ull << lane) - 1ull;
#pragma unroll
            for (int e = 0; e < 8; ++e) { const unsigned long long mk = __ballot((e0 == e) || (e1 == e)); const int rank = __popcll(mk & below); const int o = sh[32 + e] + rank; if (e0 == e) s0 = o; if (e1 == e) s1 = o; }
            tok_s[t] = (v2i){s0, s1}; sh[64 + 2 * lane] = s0; sh[64 + 2 * lane + 1] = s1;
            const f32x2 w = tok_w[t]; const float rs = tok_r[t];
            slot_r[s0] = rs; slot_r[s1] = rs; slot_w[s0] = w.x; slot_w[s1] = w.y;
        }
        __syncthreads();
#pragma unroll
        for (int tk = 0; tk < 8; ++tk) {
            const int i = wave * 8 + tk; const int s0 = sh[64 + 2 * i], s1 = sh[64 + 2 * i + 1];
            const v4u a = xr8[tk][0], b = xr8[tk][1]; v4u w;
            w.x = pg8::pk4_fp8(bflo(a.x), bfhi(a.x), bflo(a.y), bfhi(a.y)); w.y = pg8::pk4_fp8(bflo(a.z), bfhi(a.z), bflo(a.w), bfhi(a.w));
            w.z = pg8::pk4_fp8(bflo(b.x), bfhi(b.x), bflo(b.y), bfhi(b.y)); w.w = pg8::pk4_fp8(bflo(b.z), bfhi(b.z), bflo(b.w), bfhi(b.w));
            *((v4u*)(XG + (size_t)s0 * D) + lane) = w; *((v4u*)(XG + (size_t)s1 * D) + lane) = w;
        }
        for (int e = 0; e < 8; ++e) {
            const int tot = sh[e], base = 256 * sh[16 + e] + tot, npad = 256 * (sh[16 + e + 1] - sh[16 + e]) - tot;
            for (int pr = vcu; pr < npad; pr += G) { const int row = base + pr;
                if (tid < 64) ((v4u*)(XG + (size_t)row * D))[tid] = (v4u){0u, 0u, 0u, 0u};
                if (tid == 0) { slot_r[row] = 0.f; slot_w[row] = 0.f; } }
        }
        __syncthreads();
        SEAM(12);
    }
    {
        const int pu = 13;
        if (IN(pu) || IN(pu + 1)) {
            MOE_PTRS();
            int psv = (lane < 9) ? psg[lane] : 0;
            pg8::MoeOrder<true> Su; pg8::MoeOrder<false> Sd;
#pragma unroll
            for (int e = 0; e < 9; ++e) { Su.ps[e] = __builtin_amdgcn_readlane(psv, e); Sd.ps[e] = Su.ps[e]; }
            const int NP = Su.ps[8];
            if (IN(pu)) {
                Su.p_lo = 0; Su.np = NP; Su.nN = 2 * FFE / 256; Su.nwg = NP * Su.nN; Su.G = G; Su.c = bid;
                pg8::Gemm g{(const bf16*)XG, (const bf16*)(wsp + WS_WM13), D / 2, D / 2};
                pg8::EpiUp<true> E{slot_r, HC, FFE, nullptr, 0};
                for (int rep_ = 0; rep_ < REPS(pu); ++rep_)
                pg8::gemm_phase<pg8::EpiUp<true>, pg8::MoeOrder<true>, true, true, true>(lds + RING_OFF, g, Su, E);
                SEAM(pu);
            }
            if (IN(pu + 1)) {
                const int npm = NP < pg8::TAIL_P0 ? NP : pg8::TAIL_P0;
                Sd.p_lo = 0; Sd.np = npm; Sd.nN = D / 256; Sd.nwg = npm * Sd.nN; Sd.G = G; Sd.c = bid;
                pg8::MoeTailOrder St; St.ntail = NP - npm; St.G = G; St.c = bid;
#pragma unroll
                for (int e = 0; e < 9; ++e) St.ps[e] = Sd.ps[e];
                for (int rep_ = 0; rep_ < REPS(pu + 1); ++rep_) {
                { pg8::Gemm g{(const bf16*)HC, (const bf16*)(wsp + WS_WM2), FFE / 2, FFE / 2};
                  pg8::EpiDownMoeT<false> E{slot_w, Y};
                  pg8::gemm_phase<pg8::EpiDownMoeT<false>, pg8::MoeOrder<false>, true, true, true>(lds + RING_OFF, g, Sd, E); }
                { pg8::Gemm g{(const bf16*)HC, (const bf16*)(wsp + WS_WM2), 256, FFE / 2};
                  pg8::EpiDownMoeT<true> E{slot_w, PT};
                  pg8::gemm_phase<pg8::EpiDownMoeT<true>, pg8::MoeTailOrder, true, true, true>(lds + RING_OFF, g, St, E); }
                }
                SEAM(pu + 1);
            }
        }
    }
    if (IN(15)) {
        MOE_PTRS();
        const float* gf = args.in[30]; float* out = args.out;
        f32x4 gv[4];
#pragma unroll
        for (int j = 0; j < 4; ++j) gv[j] = *((const f32x4*)gf + lane + 64 * j);
        for (int rep_ = 0; rep_ < REPS(15); ++rep_)
        for (int m0 = gw; m0 < S; m0 += 4 * NGW) {
            v2i sl[4];
#pragma unroll
            for (int b = 0; b < 4; ++b) sl[b] = tok_s[m0 + b * NGW];
            v2u xa[4][4]; unsigned ya[4][2][4];
#pragma unroll
            for (int b = 0; b < 4; ++b) {
                const v2u* xr = (const v2u*)(XB + (size_t)(m0 + b * NGW) * D) + lane;
#pragma unroll
                for (int j = 0; j < 4; ++j) xa[b][j] = xr[64 * j];
#pragma unroll
                for (int q = 0; q < 2; ++q) { const int sq = q ? sl[b].y : sl[b].x; const unsigned* y = (const unsigned*)(Y + (size_t)(sq < pg8::TAIL_P0 * 256 ? sq : 0) * D) + lane;
#pragma unroll
                    for (int j = 0; j < 4; ++j) ya[b][q][j] = y[64 * j]; }
            }
#pragma unroll
            for (int b = 0; b < 4; ++b) {
                const int m = m0 + b * NGW;
                f32x4 v[4]; float s = 0.f;
#pragma unroll
                for (int j = 0; j < 4; ++j) { const v2u a = xa[b][j]; v[j] = (f32x4){bflo(a.x), bfhi(a.x), bflo(a.y), bfhi(a.y)}; }
#pragma unroll
                for (int q = 0; q < 2; ++q) {
                    const int sq = q ? sl[b].y : sl[b].x;
                    if (sq < pg8::TAIL_P0 * 256) {
#pragma unroll
                        for (int j = 0; j < 4; ++j) { const unsigned a = ya[b][q][j]; const f32x2 lo = __builtin_amdgcn_cvt_pk_f32_fp8((int)a, false), hi = __builtin_amdgcn_cvt_pk_f32_fp8((int)a, true);
                            v[j].x += lo.x * pg8::Y8_INV; v[j].y += lo.y * pg8::Y8_INV; v[j].z += hi.x * pg8::Y8_INV; v[j].w += hi.y * pg8::Y8_INV; }
                    } else {
                        const int pl = (sq >> 8) - pg8::TAIL_P0, r = sq & 255;
                        for (int ks = 0; ks < pg8::TAIL_NKS; ++ks) { const unsigned* y = (const unsigned*)(PT + ((size_t)(ks * 8 + pl) * 256 + r) * D) + lane;
#pragma unroll
                            for (int j = 0; j < 4; ++j) { const unsigned a = y[64 * j]; const f32x2 lo = __builtin_amdgcn_cvt_pk_f32_fp8((int)a, false), hi = __builtin_amdgcn_cvt_pk_f32_fp8((int)a, true);
                                v[j].x += lo.x * pg8::Y8_INV; v[j].y += lo.y * pg8::Y8_INV; v[j].z += hi.x * pg8::Y8_INV; v[j].w += hi.y * pg8::Y8_INV; } }
                    }
                }
#pragma unroll
                for (int j = 0; j < 4; ++j) s += (v[j].x * v[j].x + v[j].y * v[j].y) + (v[j].z * v[j].z + v[j].w * v[j].w);
                const float rstd = __builtin_amdgcn_rsqf(wave_sum(s) * (1.f / D) + RMS_EPS);
                f32x4* o = (f32x4*)(out + (size_t)m * D) + lane;
#pragma unroll
                for (int j = 0; j < 4; ++j) o[64 * j] = v[j] * rstd * gv[j];
            }
        }
    }
#undef IN
#undef SEAM
}

constexpr int N_PHASES = 16;
extern "C" void kernel_launch(void* const* d_in, const int* in_sizes, int n_in, void* d_out, int out_size, void* d_ws, size_t ws_size, hipStream_t stream) {
    static int grid = 0;
    if (grid == 0) {
        if (n_in != 31 || in_sizes[0] != S * D || out_size != S * D || ws_size < WS_END) { fprintf(stderr, "kernel_launch: unexpected shapes (n_in %d, in0 %d, out %d, ws %zu < %zu); nothing launched\n", n_in, n_in > 0 ? in_sizes[0] : -1, out_size, ws_size, (size_t)WS_END); grid = -1; return; }
        int dev = 0, cus = 0, per_cu = 0;
        if (hipGetDevice(&dev) != hipSuccess || hipDeviceGetAttribute(&cus, hipDeviceAttributeMultiprocessorCount, dev) != hipSuccess) { grid = -1; return; }
        if (hipFuncSetAttribute((const void*)fwd, hipFuncAttributeMaxDynamicSharedMemorySize, LDS_BYTES) != hipSuccess) { fprintf(stderr, "kernel_launch: hipFuncSetAttribute failed\n"); grid = -1; return; }
        if (hipOccupancyMaxActiveBlocksPerMultiprocessor(&per_cu, (const void*)fwd, NWAVES * 64, LDS_BYTES) != hipSuccess || per_cu < 1) fprintf(stderr, "kernel_launch: occupancy query reports %d workgroups per CU\n", per_cu);
        (void)hipGetLastError();
        grid = cus;
        if (grid > 256) grid = 256;
    }
    if (grid < 0) return;
    if (hipMemsetAsync((char*)d_ws + WS_CTL, 0, CTL_ZERO_BYTES, stream) != hipSuccess) return;
    Args a{};
    for (int i = 0; i < 31; ++i) a.in[i] = (const float*)d_in[i];
    a.out = (float*)d_out; a.ws = (unsigned char*)d_ws;
#if MK_PER_PHASE
    for (int p = 0; p < N_PHASES; ++p) { a.ph_lo = p; a.ph_hi = p + 1; hipLaunchKernelGGL(fwd, dim3(grid), dim3(NWAVES * 64), LDS_BYTES, stream, a); }
#else
    a.ph_lo = 0; a.ph_hi = N_PHASES;
    hipLaunchKernelGGL(fwd, dim3(grid), dim3(NWAVES * 64), LDS_BYTES, stream, a);
#endif
}
```

```cpp
#include <hip/hip_runtime.h>
#include <cstdio>
#include <cstdint>

#ifndef MK_PER_PHASE
#define MK_PER_PHASE 0
#endif

namespace pg8 {
#define PG8_LAS __attribute__((address_space(3)))
#define PG8_GAS __attribute__((address_space(1)))
typedef unsigned short bf16_t;
typedef short bf16x8 __attribute__((ext_vector_type(8)));
typedef float f32x4 __attribute__((ext_vector_type(4)));
typedef unsigned u32x4 __attribute__((ext_vector_type(4)));
typedef unsigned u32x2 __attribute__((ext_vector_type(2)));
typedef int v4i_t __attribute__((ext_vector_type(4)));
typedef int v8i_t __attribute__((ext_vector_type(8)));
constexpr int BM = 256, BK = 64, HALF = 128, HTB = HALF * BK * 2  , STAGE_BYTES = 8 * HTB, NXCD = 8, WGM = 8;

__host__ __device__ __forceinline__ int lds_byte(int r, int c) { const int st = (r >> 4) * 2 + (c >> 5), rr = r & 15, cc = c & 31, ob = rr * 64 + cc * 2; return st * 1024 + (ob ^ (((ob >> 9) & 1) << 5)); }
__host__ __device__ __forceinline__ void stage_rc(int b, int& R, int& C) { const int st = b / 1024, sb = b % 1024, swz = sb ^ (((sb >> 9) & 1) << 5); R = (st >> 1) * 16 + swz / 64; C = (st & 1) * 32 + (swz % 64) / 2; }
__host__ __device__ __forceinline__ int perm32(int rho) { const int n = rho >> 4, i = rho & 15; return 8 * (i >> 2) + 4 * n + (i & 3); }

struct Unit { int pa, pn, bn, po, koff; };
struct NoPre {};
struct Gemm { const bf16_t* A; const bf16_t* Bt; int K, pitch; };

struct StaticOrder {
    int nM, nN, nwg, G, c, pn0;
    __device__ __forceinline__ void init(int nM_, int nN_, int G_, int c_, int pn0_ = 0) { nM = nM_; nN = nN_; nwg = nM * nN; G = G_; c = c_; pn0 = pn0_; }
    __device__ __forceinline__ bool next(int i, Unit& u) const {
        const long L = (long)i * G + c; if (L >= nwg) return false;
        int wgid = (int)L; { const int q = nwg / NXCD, r = nwg % NXCD, xcd = wgid % NXCD, off = wgid / NXCD; wgid = (xcd < r ? xcd * (q + 1) : r * (q + 1) + (xcd - r) * q) + off; }
        const int nig = WGM * nN, gid = wgid / nig, fm = gid * WGM, gsz = (nM - fm) < WGM ? (nM - fm) : WGM;
        u.pa = fm + ((wgid % nig) % gsz); u.pn = pn0 + (wgid % nig) / gsz; u.bn = u.pn; u.po = u.pa; u.koff = 0; return true;
    }
};
template <bool UP> struct MoeOrder {
    int p_lo, np, nN, nwg, G, c; int ps[9];
    __device__ __forceinline__ bool next(int i, Unit& u) const {
        const long L = (long)i * G + c; if (L >= nwg) return false;
        int wgid = (int)L; { const int q = nwg / NXCD, r = nwg % NXCD, xcd = wgid % NXCD, off = wgid / NXCD; wgid = (xcd < r ? xcd * (q + 1) : r * (q + 1) + (xcd - r) * q) + off; }
        const int nig = WGM * nN, gid = wgid / nig, fm = gid * WGM, gsz = (np - fm) < WGM ? (np - fm) : WGM;
        const int pl = fm + ((wgid % nig) % gsz), pn = (wgid % nig) / gsz, p = p_lo + pl;
        int e = 0;
#pragma unroll
        for (int j = 1; j < 8; ++j) e += (ps[j] <= p) ? 1 : 0;
        u.pn = pn; u.bn = e * nN + pn; u.pa = UP ? p : pl; u.po = UP ? pl : p; u.koff = 0; return true;
    }
};

typedef __bf16 bf16v2_t __attribute__((ext_vector_type(2)));
typedef float f32v2_t __attribute__((ext_vector_type(2)));
constexpr int TAIL_P0 = 128, TAIL_NKS = 7;
struct MoeTailOrder {
    int ntail, G, c; int ps[9];
    __device__ __forceinline__ bool next(int i, Unit& u) const {
        const long L = (long)i * G + c; if (L >= (long)ntail * 4 * TAIL_NKS) return false;
        const int ks = (int)L % TAIL_NKS, tile = (int)L / TAIL_NKS, pl = tile >> 2, pn = tile & 3, p = TAIL_P0 + pl;
        int e = 0;
#pragma unroll
        for (int j = 1; j < 8; ++j) e += (ps[j] <= p) ? 1 : 0;
        u.pa = p; u.pn = pn; u.bn = e * 4 + pn; u.po = ks * 8 + pl; u.koff = ks * 512; return true;
    }
};

__device__ __forceinline__ unsigned cvt_pk_bf16(float lo, float hi) { const f32v2_t f = {lo, hi}; const bf16v2_t b = __builtin_convertvector(f, bf16v2_t); return __builtin_bit_cast(unsigned, b); }
__device__ __forceinline__ float bflo(unsigned w) { return __uint_as_float(w << 16); }
__device__ __forceinline__ float bfhi(unsigned w) { return __uint_as_float(w & 0xffff0000u); }
__device__ __forceinline__ float sigmoid_f(float x) { return __builtin_amdgcn_rcpf(1.0f + __builtin_amdgcn_exp2f(-1.4426950408889634f * x)); }
__device__ __forceinline__ u32x4 pack8(const f32x4& a, const f32x4& b) { u32x4 w; w.x = cvt_pk_bf16(a[0], a[1]); w.y = cvt_pk_bf16(a[2], a[3]); w.z = cvt_pk_bf16(b[0], b[1]); w.w = cvt_pk_bf16(b[2], b[3]); return w; }
__device__ __forceinline__ unsigned pk4_fp8(float a, float b, float c, float d) {
    a = __builtin_amdgcn_fmed3f(a, -448.f, 448.f); b = __builtin_amdgcn_fmed3f(b, -448.f, 448.f); c = __builtin_amdgcn_fmed3f(c, -448.f, 448.f); d = __builtin_amdgcn_fmed3f(d, -448.f, 448.f);
    int w = 0; w = __builtin_amdgcn_cvt_pk_fp8_f32(a, b, w, false); w = __builtin_amdgcn_cvt_pk_fp8_f32(c, d, w, true); return (unsigned)w; }
__device__ __forceinline__ void unpack8(const u32x4& w, f32x4& a, f32x4& b) { a[0] = bflo(w.x); a[1] = bfhi(w.x); a[2] = bflo(w.y); a[3] = bfhi(w.y); b[0] = bflo(w.z); b[1] = bfhi(w.z); b[2] = bflo(w.w); b[3] = bfhi(w.w); }
__device__ __forceinline__ void rows_rstd(const float* ss, int row0, int fq, float (&rs)[2][4]) {
    f32x4 pv[2][4];
#pragma unroll
    for (int ai = 0; ai < 2; ++ai)
#pragma unroll
        for (int m = 0; m < 4; ++m) pv[ai][m] = *(const f32x4*)(ss + (size_t)(row0 + ai * HALF + m * 16) * 16 + 4 * fq);
#pragma unroll
    for (int ai = 0; ai < 2; ++ai)
#pragma unroll
        for (int m = 0; m < 4; ++m) { const f32x4 v = pv[ai][m]; float s = (v[0] + v[1]) + (v[2] + v[3]); s += __shfl_xor(s, 16); s += __shfl_xor(s, 32); rs[ai][m] = __builtin_amdgcn_rsqf(s * (1.0f / 1024.0f) + 1e-6f); }
}

__device__ __forceinline__ void rows_rstd_lds(const PG8_LAS float* tab, int pa0, const float* ss, const Unit& u, int wr, int fr, int fq, float (&rs)[2][4]) {
    if (u.po == pa0) {
#pragma unroll
        for (int ai = 0; ai < 2; ++ai)
#pragma unroll
            for (int m = 0; m < 4; ++m) rs[ai][m] = tab[wr * 64 + fr + ai * HALF + m * 16];
    } else rows_rstd(ss, u.po * BM + wr * 64 + fr, fq, rs);
}

template <int PART> struct EpiG1 {
    static constexpr bool HAS_MID = false, ACC_INIT = false;
    const float* ss; bf16_t *a, *v, *sb, *R, *Gt; const PG8_LAS float* rtab; int pa0;
    typedef NoPre Pre; __device__ __forceinline__ void pre(NoPre&, const Unit&, int, int) const {}
    __device__ __forceinline__ void mid(f32x4 (&)[2][2][4][2], const Unit&, int, int, int, int) const {}
    __device__ __forceinline__ void operator()(const f32x4 (&acc)[2][2][4][2], const Unit& u, int wr, int wc, int fr, int fq, const NoPre&) const {
        const int row0 = u.po * BM + wr * 64 + fr, cw = wc * 32 + 8 * fq, pn = u.pn;
        float rsv[2][4]; rows_rstd_lds(rtab, pa0, ss, u, wr, fr, fq, rsv);
#pragma unroll
        for (int ai = 0; ai < 2; ++ai)
#pragma unroll
            for (int m = 0; m < 4; ++m) {
                const int row = row0 + ai * HALF + m * 16;
                const float rs = rsv[ai][m];
                const float rsn = rs * -1.4426950408889634f, rs2 = rs * rs;
                if (PART == 0 && pn < 4) {
                    f32x4 o[2];
#pragma unroll
                    for (int hh = 0; hh < 2; ++hh)
#pragma unroll
                        for (int j = 0; j < 4; j += 2) { const f32x4& a1 = acc[ai][0][m][hh]; const f32x4& a2 = acc[ai][1][m][hh];
                            const f32v2_t av = {a1[j], a1[j + 1]}, gv = {a2[j], a2[j + 1]}; const f32v2_t pe = gv * rsn;
                            f32v2_t e; e.x = __builtin_amdgcn_exp2f(pe.x); e.y = __builtin_amdgcn_exp2f(pe.y); const f32v2_t d = e + 1.0f;
                            f32v2_t r; r.x = __builtin_amdgcn_rcpf(d.x); r.y = __builtin_amdgcn_rcpf(d.y); const f32v2_t ov = (av * rs) * r; o[hh][j] = ov.x; o[hh][j + 1] = ov.y; }
                    *(u32x4*)(a + (size_t)row * 512 + pn * 128 + cw) = pack8(o[0], o[1]);
                } else if (PART == 0 && pn < 8) {
                    *(u32x4*)(v + (size_t)row * 512 + (pn - 4) * 128 + cw) = pack8((acc[ai][0][m][0] * acc[ai][1][m][0]) * rs2, (acc[ai][0][m][1] * acc[ai][1][m][1]) * rs2);
                } else if (PART == 0) {
                    bf16_t* d = sb + (size_t)row * 512 + (pn - 8) * 256 + cw;
                    *(u32x4*)d = pack8(acc[ai][0][m][0] * rs, acc[ai][0][m][1] * rs); *(u32x4*)(d + 128) = pack8(acc[ai][1][m][0] * rs, acc[ai][1][m][1] * rs);
                } else {
                    f32x4 rr[2], gg[2];
#pragma unroll
                    for (int hh = 0; hh < 2; ++hh)
#pragma unroll
                        for (int j = 0; j < 4; j += 2) { const f32x4& a1 = acc[ai][0][m][hh]; const f32x4& a2 = acc[ai][1][m][hh];
                            f32v2_t ga = (f32v2_t){a1[j], a1[j + 1]} * rs, gb = (f32v2_t){a2[j], a2[j + 1]} * rs;
                            ga.x = __builtin_amdgcn_fmed3f(ga.x, -80.f, 80.f); ga.y = __builtin_amdgcn_fmed3f(ga.y, -80.f, 80.f); gb.x = __builtin_amdgcn_fmed3f(gb.x, -80.f, 80.f); gb.y = __builtin_amdgcn_fmed3f(gb.y, -80.f, 80.f);
                            const f32v2_t pa = ga * -1.4426950408889634f, pb = gb * -1.4426950408889634f;
                            f32v2_t ea, eb; ea.x = __builtin_amdgcn_exp2f(pa.x); ea.y = __builtin_amdgcn_exp2f(pa.y); eb.x = __builtin_amdgcn_exp2f(pb.x); eb.y = __builtin_amdgcn_exp2f(pb.y);
                            const f32v2_t da = ea + 1.0f, db = eb + 1.0f;
                            f32v2_t ia, ib; ia.x = __builtin_amdgcn_rcpf(da.x); ia.y = __builtin_amdgcn_rcpf(da.y); ib.x = __builtin_amdgcn_rcpf(db.x); ib.y = __builtin_amdgcn_rcpf(db.y);
                            const f32v2_t rv = db * ia; rr[hh][j] = rv.x; rr[hh][j + 1] = rv.y; gg[hh][j] = ib.x; gg[hh][j + 1] = ib.y; }
                    const size_t o = (size_t)row * 1024 + (pn - 10) * 128 + cw;
                    *(u32x4*)(R + o) = pack8(rr[0], rr[1]); *(u32x4*)(Gt + o) = pack8(gg[0], gg[1]);
                }
            }
    }
};
struct EpiG2 {
    static constexpr bool HAS_MID = true, ACC_INIT = false;
    const bf16_t *R, *Gt; bf16_t* out;
    typedef NoPre Pre; __device__ __forceinline__ void pre(NoPre&, const Unit&, int, int) const {}
    __device__ __forceinline__ void mid(f32x4 (&acc)[2][2][4][2], const Unit& u, int wr, int wc, int fr, int fq) const {
        int po_ = u.po; asm volatile("" : "+s"(po_));
        const int row0 = po_ * BM + wr * 64 + fr, cw = u.pn * BM + wc * 32 + 8 * fq;
#pragma unroll
        for (int ai = 0; ai < 2; ++ai) {
            u32x4 gv[4][2];
#pragma unroll
            for (int m = 0; m < 4; ++m)
#pragma unroll
                for (int bj = 0; bj < 2; ++bj) gv[m][bj] = *(const u32x4*)(R + (size_t)(row0 + ai * HALF + m * 16) * 1024 + cw + bj * HALF);
#pragma unroll
            for (int m = 0; m < 4; ++m)
#pragma unroll
                for (int bj = 0; bj < 2; ++bj) { f32x4 g0, g1; unpack8(gv[m][bj], g0, g1); acc[ai][bj][m][0] *= g0; acc[ai][bj][m][1] *= g1; }
            asm volatile("" ::: "memory");
        }
    }
    __device__ __forceinline__ void operator()(const f32x4 (&acc)[2][2][4][2], const Unit& u, int wr, int wc, int fr, int fq, const NoPre&) const {
        int po_ = u.po; asm volatile("" : "+s"(po_));
        const int row0 = po_ * BM + wr * 64 + fr, cw = u.pn * BM + wc * 32 + 8 * fq;
#pragma unroll
        for (int ai = 0; ai < 2; ++ai) {
            u32x4 gv[4][2];
#pragma unroll
            for (int m = 0; m < 4; ++m)
#pragma unroll
                for (int bj = 0; bj < 2; ++bj) gv[m][bj] = *(const u32x4*)(Gt + (size_t)(row0 + ai * HALF + m * 16) * 1024 + cw + bj * HALF);
#pragma unroll
            for (int m = 0; m < 4; ++m)
#pragma unroll
                for (int bj = 0; bj < 2; ++bj) { f32x4 g0, g1; unpack8(gv[m][bj], g0, g1);
                    *(u32x4*)(out + (size_t)(row0 + ai * HALF + m * 16) * 1024 + cw + bj * HALF) = pack8(acc[ai][bj][m][0] * g0, acc[ai][bj][m][1] * g1); }
            asm volatile("" ::: "memory");
        }
    }
};
template <bool AUX, bool XF32> struct EpiRes {
    static constexpr bool HAS_MID = false, ACC_INIT = true;
    const float* xin; bf16_t* xb; float* ss;
    typedef NoPre Pre; __device__ __forceinline__ void pre(NoPre&, const Unit&, int, int) const {}
    __device__ __forceinline__ void mid(f32x4 (&)[2][2][4][2], const Unit&, int, int, int, int) const {}
    __device__ __forceinline__ void init(f32x4 (&acc)[2][2][4][2], const Unit& u, int wr, int wc, int fr, int fq) const {
        const int row0 = u.po * BM + wr * 64 + fr, cw = u.pn * BM + wc * 32 + 8 * fq;
#pragma unroll
        for (int ai = 0; ai < 2; ++ai)
#pragma unroll
            for (int m = 0; m < 4; ++m)
#pragma unroll
                for (int bj = 0; bj < 2; ++bj) { const size_t o = (size_t)(row0 + ai * HALF + m * 16) * 1024 + cw + bj * HALF;
                    if (XF32) { acc[ai][bj][m][0] = *(const f32x4*)(xin + o); acc[ai][bj][m][1] = *(const f32x4*)(xin + o + 4); }
                    else unpack8(*(const u32x4*)(xb + o), acc[ai][bj][m][0], acc[ai][bj][m][1]); }
    }
    __device__ __forceinline__ void operator()(const f32x4 (&acc)[2][2][4][2], const Unit& u, int wr, int wc, int fr, int fq, const NoPre&) const {
        const int row0 = u.po * BM + wr * 64 + fr, cw = u.pn * BM + wc * 32 + 8 * fq;
#pragma unroll
        for (int ai = 0; ai < 2; ++ai)
#pragma unroll
            for (int m = 0; m < 4; ++m) {
                const int row = row0 + ai * HALF + m * 16; const size_t o = (size_t)row * 1024 + cw; float q = 0.f;
#pragma unroll
                for (int bj = 0; bj < 2; ++bj) {
                    const f32x4 o0 = acc[ai][bj][m][0], o1 = acc[ai][bj][m][1];
                    if (AUX) q += (o0[0] * o0[0] + o0[1] * o0[1]) + (o0[2] * o0[2] + o0[3] * o0[3]) + (o1[0] * o1[0] + o1[1] * o1[1]) + (o1[2] * o1[2] + o1[3] * o1[3]);
                    *(u32x4*)(xb + o + bj * HALF) = pack8(o0, o1);
                }
                if (AUX) { q += __shfl_xor(q, 16); q += __shfl_xor(q, 32); if (fq == 0) ss[(size_t)row * 16 + u.pn * 4 + wc] = q; }
            }
    }
};
constexpr float F8_WSCALE = 64.0f, F8_WINV = 1.0f / 64.0f;
template <bool MOE> struct EpiUp {
    static constexpr bool HAS_MID = false, ACC_INIT = false;
    const float* rsrc; void* hid; int ld; const PG8_LAS float* rtab; int pa0;
    struct Pre { float rs[2][4]; };
    __device__ __forceinline__ void pre(Pre& pf, const Unit& u, int wr, int fr) const {
        if (MOE) { const int row0 = u.po * BM + wr * 64 + fr;
#pragma unroll
            for (int ai = 0; ai < 2; ++ai)
#pragma unroll
                for (int m = 0; m < 4; ++m) pf.rs[ai][m] = rsrc[row0 + ai * HALF + m * 16]; } }
    __device__ __forceinline__ void mid(f32x4 (&)[2][2][4][2], const Unit&, int, int, int, int) const {}
    __device__ __forceinline__ void operator()(const f32x4 (&acc)[2][2][4][2], const Unit& u, int wr, int wc, int fr, int fq, const Pre& pf) const {
        const int row0 = u.po * BM + wr * 64 + fr, cw = u.pn * HALF + wc * 32 + 8 * fq;
        float rsv[2][4];
        if (MOE) {
#pragma unroll
            for (int ai = 0; ai < 2; ++ai)
#pragma unroll
                for (int m = 0; m < 4; ++m) rsv[ai][m] = pf.rs[ai][m] * F8_WINV;
        } else rows_rstd_lds(rtab, pa0, rsrc, u, wr, fr, fq, rsv);
#pragma unroll
        for (int ai = 0; ai < 2; ++ai)
#pragma unroll
            for (int m = 0; m < 4; ++m) {
                const int row = row0 + ai * HALF + m * 16;
                const float rs = rsv[ai][m];
                const float rsn = rs * -1.4426950408889634f, rs2 = rs * rs;
                f32x4 o0, o1;
#pragma unroll
                for (int hh = 0; hh < 2; ++hh)
#pragma unroll
                    for (int j = 0; j < 4; j += 2) {
                        const f32x4& a1 = acc[ai][0][m][hh]; const f32x4& a3 = acc[ai][1][m][hh];
                        const f32v2_t av = {a1[j], a1[j + 1]}, bv = {a3[j], a3[j + 1]};
                        const f32v2_t pe = av * rsn, pq = (av * bv) * rs2;
                        f32v2_t e; e.x = __builtin_amdgcn_exp2f(pe.x); e.y = __builtin_amdgcn_exp2f(pe.y);
                        const f32v2_t d = e + 1.0f; f32v2_t r; r.x = __builtin_amdgcn_rcpf(d.x); r.y = __builtin_amdgcn_rcpf(d.y);
                        const f32v2_t o = pq * r;
                        if (hh == 0) { o0[j] = o.x; o0[j + 1] = o.y; } else { o1[j] = o.x; o1[j + 1] = o.y; }
                    }
                if (MOE) { u32x2 w; w.x = pk4_fp8(o0[0], o0[1], o0[2], o0[3]); w.y = pk4_fp8(o1[0], o1[1], o1[2], o1[3]); *(u32x2*)((unsigned char*)hid + (size_t)row * ld + cw) = w; }
                else *(u32x4*)((bf16_t*)hid + (size_t)row * ld + cw) = pack8(o0, o1);
            }
    }
};
constexpr float Y8_SCALE = 16.0f, Y8_INV = 1.0f / 16.0f;
template <bool TAIL> struct EpiDownMoeT {
    static constexpr bool HAS_MID = false, ACC_INIT = false;
    const float* w; unsigned char* Y;
    struct Pre { float ws[2][4]; };
    __device__ __forceinline__ void pre(Pre& pf, const Unit& u, int wr, int fr) const {
        const int row0 = u.po * BM + wr * 64 + fr;
#pragma unroll
        for (int ai = 0; ai < 2; ++ai)
#pragma unroll
            for (int m = 0; m < 4; ++m) { const int row = row0 + ai * HALF + m * 16; pf.ws[ai][m] = w[TAIL ? row - (u.po - (u.po & 7)) * BM + TAIL_P0 * BM : row]; } }
    __device__ __forceinline__ void mid(f32x4 (&)[2][2][4][2], const Unit&, int, int, int, int) const {}
    __device__ __forceinline__ void operator()(const f32x4 (&acc)[2][2][4][2], const Unit& u, int wr, int wc, int fr, int fq, const Pre& pf) const {
        const int row0 = u.po * BM + wr * 64 + fr, cw = u.pn * BM + wc * 32 + 8 * fq;
#pragma unroll
        for (int ai = 0; ai < 2; ++ai)
#pragma unroll
            for (int m = 0; m < 4; ++m) {
                const int row = row0 + ai * HALF + m * 16; const float ws = pf.ws[ai][m] * (F8_WINV * Y8_SCALE); const size_t o = (size_t)row * 1024 + cw;
#pragma unroll
                for (int bj = 0; bj < 2; ++bj) { const f32x4 v0 = acc[ai][bj][m][0] * ws, v1 = acc[ai][bj][m][1] * ws; u32x2 pk; pk.x = pk4_fp8(v0[0], v0[1], v0[2], v0[3]); pk.y = pk4_fp8(v1[0], v1[1], v1[2], v1[3]); *(u32x2*)(Y + o + bj * HALF) = pk; }
            }
    }
};

template <class Epi, class Sched, bool ALIGN_EPI = false, bool SP2 = false, bool F8 = false>
__device__ __forceinline__ void gemm_phase(PG8_LAS unsigned char* lds, const Gemm g, const Sched& S, const Epi& E) {
    int tid_ = threadIdx.x; asm volatile("" : "+v"(tid_));
    const int tid = tid_, wid = __builtin_amdgcn_readfirstlane(tid >> 6), lane = tid & 63, wr = wid >> 2, wc = wid & 3, fr = lane & 15, fq = lane >> 4;
    const int K = g.pitch, nt = g.K / BK;
    unsigned voffA[2], voffB[2];
#pragma unroll
    for (int i = 0; i < 2; ++i) { int R, C; stage_rc(tid * 16 + i * 8192, R, C); const int Rb = (R & ~31) + perm32(R & 31);
        voffA[i] = (unsigned)(R * K + C) * 2u; voffB[i] = (unsigned)(Rb * K + C) * 2u; }
    const size_t kstep = (size_t)(BK * 2);
    const size_t hstep = (size_t)HALF * K * 2;
    const size_t tstep = 2 * hstep;
    const unsigned ldsw = (unsigned)wid * 1024u;
    const int aoff = lds_byte(wr * 64 + fr, fq * 8), boff = lds_byte(wc * 32 + fr, fq * 8);
#define PG8_SA(b, h) (((b) * 2 + (h)) * HTB)
#define PG8_SB(b, h) ((4 + (b) * 2 + (h)) * HTB)
#define PG8_STAGE(bufoff, gbase, voff) do { _Pragma("unroll") for (int _i = 0; _i < 2; ++_i) \
        __builtin_amdgcn_global_load_lds((const PG8_GAS unsigned*)((gbase) + (voff)[_i]), (PG8_LAS unsigned*)(lds + (bufoff) + ldsw + _i * 8192), 16, 0, 0); } while (0)
#define PG8_LDA(dst, b, h) do { _Pragma("unroll") for (int m = 0; m < 4; ++m) _Pragma("unroll") for (int k = 0; k < 2; ++k) dst[m][k] = *(const PG8_LAS bf16x8*)(lds + PG8_SA(b, h) + aoff + m * 2048 + k * 1024); } while (0)
#define PG8_LDB(dst, b, h) do { _Pragma("unroll") for (int n = 0; n < 2; ++n) _Pragma("unroll") for (int k = 0; k < 2; ++k) dst[n][k] = *(const PG8_LAS bf16x8*)(lds + PG8_SB(b, h) + boff + n * 2048 + k * 1024); } while (0)
#define PG8_MMA(ai, bj, At, Bt) do { __builtin_amdgcn_s_setprio(1); if constexpr (F8) { _Pragma("unroll") for (int m = 0; m < 4; ++m) _Pragma("unroll") for (int n = 0; n < 2; ++n) { \
            const v8i_t a8 = __builtin_shufflevector(__builtin_bit_cast(v4i_t, At[m][0]), __builtin_bit_cast(v4i_t, At[m][1]), 0, 1, 2, 3, 4, 5, 6, 7), b8 = __builtin_shufflevector(__builtin_bit_cast(v4i_t, Bt[n][0]), __builtin_bit_cast(v4i_t, Bt[n][1]), 0, 1, 2, 3, 4, 5, 6, 7); \
            asm volatile("v_mfma_scale_f32_16x16x128_f8f6f4 %0, %1, %2, %0, %3, %3 op_sel_hi:[0,0,0]" : "+v"(acc[ai][bj][m][n]) : "v"(b8), "v"(a8), "v"(f8_unit_scale)); } } else { \
        _Pragma("unroll") for (int m = 0; m < 4; ++m) _Pragma("unroll") for (int n = 0; n < 2; ++n) _Pragma("unroll") for (int k = 0; k < 2; ++k) \
        acc[ai][bj][m][n] = __builtin_amdgcn_mfma_f32_16x16x32_bf16(Bt[n][k], At[m][k], acc[ai][bj][m][n], 0, 0, 0); } __builtin_amdgcn_s_setprio(0); } while (0)
#define PG8_WAIT_V(n) asm volatile("s_waitcnt vmcnt(" #n ")" ::: "memory")
#define PG8_WAIT_L(n) asm volatile("s_waitcnt lgkmcnt(" #n ")" ::: "memory")
#define PG8_BAR __builtin_amdgcn_s_barrier()
#define PG8_SCHED __builtin_amdgcn_sched_barrier(0)
    Unit cur, nxt; int ui = 0;
    if (!S.next(0, cur)) return;
    cur.pa = __builtin_amdgcn_readfirstlane(cur.pa); cur.pn = __builtin_amdgcn_readfirstlane(cur.pn); cur.bn = __builtin_amdgcn_readfirstlane(cur.bn); cur.po = __builtin_amdgcn_readfirstlane(cur.po); cur.koff = __builtin_amdgcn_readfirstlane(cur.koff);
    f32x4 acc[2][2][4][2];
    typename Epi::Pre pf;
    const int f8_unit_scale = 0x7F7F7F7F;
    (void)f8_unit_scale;
    if constexpr (Epi::ACC_INIT) E.init(acc, cur, wr, wc, fr, fq);
    else {
#pragma unroll
    for (int a = 0; a < 2; ++a)
#pragma unroll
        for (int b = 0; b < 2; ++b)
#pragma unroll
            for (int m = 0; m < 4; ++m)
#pragma unroll
                for (int n = 0; n < 2; ++n) acc[a][b][m][n] = (f32x4){0.f, 0.f, 0.f, 0.f};
    }
    bf16x8 At[4][2], B0[2][2], B1[2][2];
    const PG8_GAS char* cA = (const PG8_GAS char*)g.A + (size_t)cur.pa * tstep + cur.koff; const PG8_GAS char* cB = (const PG8_GAS char*)g.Bt + (size_t)cur.bn * tstep + cur.koff;
    if constexpr (SP2) {
        PG8_STAGE(PG8_SB(0, 0), cB, voffB); PG8_STAGE(PG8_SB(0, 1), cB + hstep, voffB); PG8_STAGE(PG8_SA(0, 0), cA, voffA); PG8_STAGE(PG8_SA(0, 1), cA + hstep, voffA);
        if (wr == 1) PG8_BAR;
        PG8_WAIT_V(2); PG8_BAR;
        PG8_STAGE(PG8_SB(1, 0), cB + kstep, voffB); PG8_STAGE(PG8_SA(1, 0), cA + kstep, voffA); PG8_STAGE(PG8_SB(1, 1), cB + hstep + kstep, voffB);
        PG8_WAIT_V(6); PG8_BAR;
    } else {
        PG8_STAGE(PG8_SB(0, 0), cB, voffB); PG8_STAGE(PG8_SA(0, 0), cA, voffA); PG8_STAGE(PG8_SB(0, 1), cB + hstep, voffB); PG8_STAGE(PG8_SA(0, 1), cA + hstep, voffA);
        if (wr == 1) PG8_BAR;
        PG8_WAIT_V(4); PG8_BAR;
        PG8_STAGE(PG8_SB(1, 0), cB + kstep, voffB); PG8_STAGE(PG8_SA(1, 0), cA + kstep, voffA); PG8_STAGE(PG8_SB(1, 1), cB + hstep + kstep, voffB);
        PG8_WAIT_V(6); PG8_BAR;
    }
    for (;;) {
        const bool has_next = S.next(ui + 1, nxt);
        nxt.pa = __builtin_amdgcn_readfirstlane(nxt.pa); nxt.pn = __builtin_amdgcn_readfirstlane(nxt.pn); nxt.bn = __builtin_amdgcn_readfirstlane(nxt.bn); nxt.po = __builtin_amdgcn_readfirstlane(nxt.po); nxt.koff = __builtin_amdgcn_readfirstlane(nxt.koff);
        const PG8_GAS char* nA = has_next ? (const PG8_GAS char*)g.A + (size_t)nxt.pa * tstep + nxt.koff : cA; const PG8_GAS char* nB = has_next ? (const PG8_GAS char*)g.Bt + (size_t)nxt.bn * tstep + nxt.koff : cB;
        for (int kh = 0; kh < (Epi::HAS_MID ? 2 : 1); ++kh) {
        const int t_lo = Epi::HAS_MID ? kh * (nt >> 1) : 0, t_hi = Epi::HAS_MID ? (kh + 1) * (nt >> 1) : nt;
#pragma unroll 1
        for (int t = t_lo; t < t_hi; t += 2) {
            const bool last = (t == nt - 2);
            if (last) E.pre(pf, cur, wr, fr);
            const PG8_GAS char* a1 = cA + (size_t)(t + 1) * kstep;
            const PG8_GAS char* a2 = last ? nA : cA + (size_t)(t + 2) * kstep; const PG8_GAS char* b2 = last ? nB : cB + (size_t)(t + 2) * kstep;
            const PG8_GAS char* a3 = a2 + kstep; const PG8_GAS char* b3 = b2 + kstep;
            if constexpr (SP2) {
            PG8_LDB(B0, 0, 0); PG8_LDB(B1, 0, 1); PG8_SCHED; PG8_LDA(At, 0, 0); PG8_STAGE(PG8_SA(1, 1), a1 + hstep, voffA);
            PG8_WAIT_V(8); PG8_WAIT_L(0); PG8_BAR; PG8_MMA(0, 0, At, B0); PG8_MMA(0, 1, At, B1); PG8_BAR; PG8_SCHED;
            PG8_LDA(At, 0, 1); PG8_STAGE(PG8_SB(0, 0), b2, voffB); PG8_STAGE(PG8_SB(0, 1), b2 + hstep, voffB); PG8_STAGE(PG8_SA(0, 0), a2, voffA);
            PG8_WAIT_V(8); PG8_WAIT_L(0); PG8_BAR; PG8_MMA(1, 0, At, B0); PG8_MMA(1, 1, At, B1); PG8_BAR; PG8_SCHED;
            PG8_LDB(B0, 1, 0); PG8_LDB(B1, 1, 1); PG8_SCHED; PG8_LDA(At, 1, 0); PG8_STAGE(PG8_SA(0, 1), a2 + hstep, voffA);
            PG8_WAIT_V(8); PG8_WAIT_L(0); PG8_BAR; PG8_MMA(0, 0, At, B0); PG8_MMA(0, 1, At, B1); PG8_BAR; PG8_SCHED;
            PG8_LDA(At, 1, 1); PG8_STAGE(PG8_SB(1, 0), b3, voffB); PG8_STAGE(PG8_SB(1, 1), b3 + hstep, voffB); PG8_STAGE(PG8_SA(1, 0), a3, voffA);
            PG8_WAIT_V(8); PG8_WAIT_L(0); PG8_BAR; PG8_MMA(1, 0, At, B0); PG8_MMA(1, 1, At, B1); PG8_BAR; PG8_SCHED;
            } else {
            PG8_LDB(B0, 0, 0); PG8_SCHED; PG8_LDA(At, 0, 0); PG8_STAGE(PG8_SA(1, 1), a1 + hstep, voffA);
            PG8_WAIT_L(8); PG8_BAR; PG8_WAIT_L(0); PG8_MMA(0, 0, At, B0); PG8_BAR; PG8_SCHED;
            PG8_LDB(B1, 0, 1); PG8_STAGE(PG8_SB(0, 0), b2, voffB);
            PG8_BAR; PG8_WAIT_L(0); PG8_MMA(0, 1, At, B1); PG8_BAR;
            PG8_LDA(At, 0, 1); PG8_STAGE(PG8_SA(0, 0), a2, voffA);
            PG8_BAR; PG8_WAIT_L(0); PG8_MMA(1, 0, At, B0); PG8_BAR; PG8_SCHED;
            PG8_STAGE(PG8_SB(0, 1), b2 + hstep, voffB);
            PG8_WAIT_V(6); PG8_BAR; PG8_MMA(1, 1, At, B1); PG8_BAR;
            PG8_LDB(B0, 1, 0); PG8_SCHED; PG8_LDA(At, 1, 0); PG8_STAGE(PG8_SA(0, 1), a2 + hstep, voffA);
            PG8_WAIT_L(8); PG8_BAR; PG8_WAIT_L(0); PG8_MMA(0, 0, At, B0); PG8_BAR; PG8_SCHED;
            PG8_LDB(B1, 1, 1); PG8_STAGE(PG8_SB(1, 0), b3, voffB);
            PG8_BAR; PG8_WAIT_L(0); PG8_MMA(0, 1, At, B1); PG8_BAR;
            PG8_LDA(At, 1, 1); PG8_STAGE(PG8_SA(1, 0), a3, voffA);
            PG8_BAR; PG8_WAIT_L(0); PG8_MMA(1, 0, At, B0); PG8_BAR; PG8_SCHED;
            PG8_STAGE(PG8_SB(1, 1), b3 + hstep, voffB);
            PG8_WAIT_V(6); PG8_BAR; PG8_MMA(1, 1, At, B1); PG8_BAR;
            }
        }
        if (Epi::HAS_MID && kh == 0) E.mid(acc, cur, wr, wc, fr, fq);
        }
        if constexpr (ALIGN_EPI) { if (wr == 0) PG8_BAR; }
        E(acc, cur, wr, wc, fr, fq, pf);
        if (!has_next) break;
        if constexpr (Epi::ACC_INIT) E.init(acc, nxt, wr, wc, fr, fq);
        else {
#pragma unroll
        for (int a = 0; a < 2; ++a)
#pragma unroll
            for (int b = 0; b < 2; ++b)
#pragma unroll
                for (int m = 0; m < 4; ++m)
#pragma unroll
                    for (int n = 0; n < 2; ++n) acc[a][b][m][n] = (f32x4){0.f, 0.f, 0.f, 0.f};
        }
        cur = nxt; cA = nA; cB = nB; ++ui;
        if constexpr (ALIGN_EPI) { if (wr == 1) PG8_BAR; }
    }
    PG8_WAIT_V(0);
    if constexpr (!ALIGN_EPI) { if (wr == 0) PG8_BAR; }
    PG8_BAR;
#undef PG8_SA
#undef PG8_SB
#undef PG8_STAGE
#undef PG8_LDA
#undef PG8_LDB
#undef PG8_MMA
#undef PG8_WAIT_V
#undef PG8_WAIT_L
#undef PG8_BAR
#undef PG8_SCHED
}
}

constexpr int NWAVES = 8;
constexpr int S = 16384, D = 1024, DC = 512, NIN = 4608, FF0 = 2816, FFE = 3584, NE = 8;
constexpr int MAXP = 136;
constexpr float RMS_EPS = 1e-6f, LNC_EPS = 1e-5f;

constexpr size_t MiB = 1u << 20;
constexpr size_t WS_CTL = 0, CTL_ZERO_BYTES = 32 * 1024;
constexpr size_t WS_SS = 1 * MiB;
constexpr size_t WS_TOKE = 2 * MiB, WS_TOKW = WS_TOKE + 64 * 1024, WS_TOKR = WS_TOKW + 128 * 1024, WS_TOKS = WS_TOKR + 64 * 1024, WS_CNT = WS_TOKS + 128 * 1024, WS_PS = WS_CNT + 8 * 1024;
constexpr size_t WS_SLOTR = 3 * MiB, WS_SLOTW = WS_SLOTR + 256 * 1024;
constexpr size_t WS_WM13 = 68 * MiB, WS_WM2 = 124 * MiB;
constexpr size_t WS_WL1 = 152 * MiB, WS_WL0 = 165 * MiB;
constexpr size_t WO_IN = 0, WO_AB = 9 * MiB, WO_O = 11 * MiB, WO_13 = 13 * MiB, WO_2 = 24 * MiB;
constexpr size_t WS_XB = 4 * MiB;
constexpr size_t WS_MG = 36 * MiB;
constexpr size_t WS_POOL = 195 * MiB;
constexpr size_t PO_A = 0, PO_V = 16 * MiB, PO_SB = 32 * MiB, PO_R = 48 * MiB, PO_G = 80 * MiB, PO_A2 = 112 * MiB, PO_HID = 144 * MiB, PO_A1 = 232 * MiB, PO_V1 = 248 * MiB;
constexpr size_t WS_XG = 152 * MiB;
constexpr size_t WS_Y = 186 * MiB;
constexpr size_t WS_HC = 254 * MiB;
constexpr size_t WS_PT = 373 * MiB;
constexpr size_t WS_END = 459 * MiB;
static_assert(WS_XG + (size_t)MAXP * 256 * D <= WS_Y && WS_Y + (size_t)MAXP * 256 * D * 2 <= WS_HC && WS_HC + (size_t)MAXP * 256 * FFE <= WS_END && WS_POOL + PO_HID + (size_t)S * FF0 * 2 <= WS_POOL + PO_A1 && WS_POOL + PO_V1 + 16 * MiB <= WS_END && WS_POOL + PO_A2 + 32 * MiB <= WS_POOL + PO_HID, "d_ws map");
static_assert(WS_XB + (size_t)S * D * 2 <= WS_MG && WS_MG + (size_t)S * D * 2 <= WS_WM13 && WS_WL0 + WO_2 + (size_t)D * FF0 * 2 <= WS_POOL && WS_WM2 + (size_t)NE * D * FFE <= WS_WL1 && WS_WM13 + (size_t)NE * 2 * FFE * D <= WS_WM2 && WS_WL1 + 13 * MiB <= WS_WL0, "weight map");
constexpr int CW_BAR = 4096;
constexpr int CW_XID = 1024;
constexpr int CW_TEAM = 2048;
static_assert((CW_BAR + 3456) * 4 <= (int)CTL_ZERO_BYTES && CW_TEAM + 64 * 16 <= CW_BAR, "barrier words inside the per-call memset");

constexpr int RING_OFF = 0, RING_BYTES = 131072;
constexpr int LDSCTL_OFF = RING_BYTES, MISC_OFF = LDSCTL_OFF + 320;
constexpr int LDS_BYTES = 147456;

#define GAS __attribute__((address_space(1)))
#define LAS __attribute__((address_space(3)))
typedef unsigned short bf16;
typedef unsigned v4u __attribute__((ext_vector_type(4)));
typedef unsigned v2u __attribute__((ext_vector_type(2)));
typedef int v4i __attribute__((ext_vector_type(4)));
typedef int v2i __attribute__((ext_vector_type(2)));
typedef float f32x4 __attribute__((ext_vector_type(4)));
typedef float f32x2 __attribute__((ext_vector_type(2)));
#define LDS_WAIT() asm volatile("s_waitcnt lgkmcnt(0)" ::: "memory")
#define VM_WAIT() asm volatile("s_waitcnt vmcnt(0)" ::: "memory")
using pg8::cvt_pk_bf16; using pg8::bflo; using pg8::bfhi; using pg8::sigmoid_f;

#define XB_TMO      128
#define XB_XCNT(j)  (256  + 64 * (j))
#define XB_XSUB(j)  (1280 + 64 * (j))
#define XB_XGEN(j)  (2304 + 64 * (j))
#define XB_TOP      3328
#define XB_TOPGEN   3392
#define XCD_BAR_WORDS 3456
#define XB_SPIN_CAP (1u << 18)

__device__ __forceinline__ unsigned xb_ld(unsigned* p)              { return __hip_atomic_load(p, __ATOMIC_RELAXED, __HIP_MEMORY_SCOPE_AGENT); }
__device__ __forceinline__ unsigned xb_add(unsigned* p, unsigned v) { return __hip_atomic_fetch_add(p, v, __ATOMIC_RELAXED, __HIP_MEMORY_SCOPE_AGENT); }
__device__ __forceinline__ unsigned xb_xcc_id() { return (unsigned)__builtin_amdgcn_s_getreg((3 << 11) | 20) & 0xFu; }
#define XB_SPIN(cond, bar) do { unsigned _sp = 0; while (cond) { __builtin_amdgcn_s_sleep(1); \
    if ((++_sp & 255u) == 0u) { if (xb_ld(&(bar)[XB_TMO])) break; if (_sp > XB_SPIN_CAP) { atomicAdd(&(bar)[XB_TMO], 1u); break; } } } } while (0)

struct XcdBarrier {
    unsigned* bar; unsigned x;
    volatile LAS unsigned* st;
};
__device__ __forceinline__ XcdBarrier xcd_barrier_post(unsigned* bar, volatile LAS unsigned* st) {
    XcdBarrier b; b.bar = bar; b.x = xb_xcc_id(); b.st = st;
    if (threadIdx.x == 0) (void)xb_add(&bar[XB_XCNT(b.x)], 1u);
    return b;
}
__device__ __forceinline__ void xcd_barrier_complete(unsigned* bar, unsigned x, unsigned& nloc, unsigned& nx) {
    const unsigned G = gridDim.x * gridDim.y * gridDim.z;
    unsigned sum, cnt, mine, sp = 0u;
    for (;;) {
        sum = 0u; cnt = 0u; mine = 0u;
#pragma unroll
        for (unsigned j = 0; j < 16; ++j) { const unsigned c = xb_ld(&bar[XB_XCNT(j)]); sum += c; cnt += (c > 0u) ? 1u : 0u; mine = (j == x) ? c : mine; }
        if (sum == G) break;
        __builtin_amdgcn_s_sleep(1);
        if ((++sp & 255u) == 0u) { if (xb_ld(&bar[XB_TMO])) break; if (sp > XB_SPIN_CAP) { atomicAdd(&bar[XB_TMO], 1u); break; } }
    }
    nloc = mine > 0u ? mine : 1u; nx = cnt > 0u ? cnt : 1u;
}
__device__ __forceinline__ void xcd_barrier(const XcdBarrier& b) {
    asm volatile("s_waitcnt vmcnt(0)" ::: "memory");
    __syncthreads();
    if (threadIdx.x == 0) {
        unsigned* bar = b.bar;
        __builtin_amdgcn_s_waitcnt(0);
        unsigned nloc = b.st[0], nx = b.st[1];
        if (nloc == 0u) { xcd_barrier_complete(bar, b.x, nloc, nx); b.st[0] = nloc; b.st[1] = nx; }
        const unsigned old = xb_add(&bar[XB_XSUB(b.x)], 1u);
        const unsigned gen = old / nloc;
        if (old + 1u == (gen + 1u) * nloc) {
            __builtin_amdgcn_fence(__ATOMIC_RELEASE, "agent");
            asm volatile("s_waitcnt vmcnt(0)" ::: "memory");
            const unsigned og = xb_add(&bar[XB_TOP], 1u);
            const unsigned tg = og / nx;
            if (og + 1u == (tg + 1u) * nx) xb_add(&bar[XB_TOPGEN], 1u);
            else XB_SPIN(xb_ld(&bar[XB_TOPGEN]) == tg, bar);
            __builtin_amdgcn_fence(__ATOMIC_ACQUIRE, "agent");
            xb_add(&bar[XB_XGEN(b.x)], 1u);
            asm volatile("s_waitcnt vmcnt(0)" ::: "memory");
        } else {
            XB_SPIN(xb_ld(&bar[XB_XGEN(b.x)]) == gen, bar);
            __builtin_amdgcn_fence(__ATOMIC_ACQUIRE, "agent");
            asm volatile("s_waitcnt vmcnt(0)" ::: "memory");
        }
    }
    __syncthreads();
}

__device__ __forceinline__ void team_barrier(unsigned* cnt, unsigned target, bool coloc, unsigned* tmo_bar, unsigned* prev = nullptr) {
    asm volatile("s_waitcnt vmcnt(0)" ::: "memory");
    __syncthreads();
    if (threadIdx.x == 0) {
        __builtin_amdgcn_s_waitcnt(0);
        if (!coloc) { __builtin_amdgcn_fence(__ATOMIC_RELEASE, "agent"); asm volatile("s_waitcnt vmcnt(0)" ::: "memory"); }
        (void)xb_add(cnt, 1u);
        XB_SPIN(xb_ld(cnt) < target, tmo_bar);
        if (prev) XB_SPIN(xb_ld(prev) < target, tmo_bar);
        __builtin_amdgcn_fence(__ATOMIC_ACQUIRE, "agent");
        asm volatile("s_waitcnt vmcnt(0)" ::: "memory");
    }
    __syncthreads();
}

__device__ __forceinline__ float wave_sum(float v) {
#pragma unroll
    for (int o = 1; o < 64; o <<= 1) v += __shfl_xor(v, o);
    return v;
}
template <bool F8> __device__ __forceinline__ void tr_load(const float* src, int spitch, int scol0, const float* scale, float sc0, int k0, int lane, unsigned (&pa)[F8 ? 16 : 32], unsigned (&pb)[F8 ? 16 : 32]) {
    const int h = lane >> 5, c = lane & 31;
    const float* s = src + (size_t)(k0 + h) * spitch + scol0 + 4 * c;
    f32x4 x[32];
#pragma unroll
    for (int i = 0; i < 32; ++i) x[i] = __builtin_nontemporal_load((const f32x4*)(s + (size_t)(2 * i) * spitch));
#pragma unroll
    for (int i = 0; i < 32; i += 2) {
        float ea[2], oa[2], eb[2], ob[2];
#pragma unroll
        for (int d = 0; d < 2; ++d) {
            const float sk = scale ? scale[k0 + 2 * (i + d) + h] * sc0 : sc0;
            const f32x4 y = x[i + d] * sk;
            auto r = __builtin_amdgcn_permlane32_swap(__float_as_uint(y.x), __float_as_uint(y.z), false, false); ea[d] = __uint_as_float(r[0]); oa[d] = __uint_as_float(r[1]);
            auto q = __builtin_amdgcn_permlane32_swap(__float_as_uint(y.y), __float_as_uint(y.w), false, false); eb[d] = __uint_as_float(q[0]); ob[d] = __uint_as_float(q[1]);
        }
        if (F8) { pa[i >> 1] = pg8::pk4_fp8(ea[0], oa[0], ea[1], oa[1]); pb[i >> 1] = pg8::pk4_fp8(eb[0], ob[0], eb[1], ob[1]); }
        else { pa[i] = cvt_pk_bf16(ea[0], oa[0]); pa[i + 1] = cvt_pk_bf16(ea[1], oa[1]); pb[i] = cvt_pk_bf16(eb[0], ob[0]); pb[i + 1] = cvt_pk_bf16(eb[1], ob[1]); }
    }
}
__device__ __forceinline__ void tr_item(const float* src, int spitch, int scol0, const float* scale, bf16* dst, int dpitch, int drow0, int dk0, int k0, int lane, LAS unsigned char* tile) {
    unsigned pa[32], pb[32];
    tr_load<false>(src, spitch, scol0, scale, 1.0f, k0, lane, pa, pb);
    const int ra = 4 * (lane & 31) + 2 * (lane >> 5), sa = (ra >> 1) & 7;
#pragma unroll
    for (int j = 0; j < 8; ++j) {
        *(LAS v4u*)(tile + ra * 128 + ((j ^ sa) << 4)) = (v4u){pa[4 * j], pa[4 * j + 1], pa[4 * j + 2], pa[4 * j + 3]};
        *(LAS v4u*)(tile + (ra + 1) * 128 + ((j ^ sa) << 4)) = (v4u){pb[4 * j], pb[4 * j + 1], pb[4 * j + 2], pb[4 * j + 3]};
    }
#pragma unroll
    for (int jj = 0; jj < 16; ++jj) { const int r = (lane >> 3) + 8 * jj, pc = lane & 7, ch = pc ^ ((r >> 1) & 7);
        const v4u v = *(const LAS v4u*)(tile + r * 128 + (pc << 4));
        *(v4u*)(dst + (size_t)(drow0 + r) * dpitch + dk0 + k0 + 8 * ch) = v; }
}
template <int HALF> __device__ __forceinline__ void tr_item_f8(const float* src, int spitch, int scol0, const float* scale, unsigned char* dst, int dpitch, int drow0, int k0, int lane, LAS unsigned char* tile) {
    const int ra = 4 * (lane & 31) + 2 * (lane >> 5), sa = (ra >> 1) & 7;
#pragma unroll 1
    for (int hf = (HALF < 0 ? 0 : HALF); hf < (HALF < 0 ? 2 : HALF + 1); ++hf) {
        unsigned pa[16], pb[16];
        tr_load<true>(src, spitch, scol0, scale, pg8::F8_WSCALE, k0 + 64 * hf, lane, pa, pb);
#pragma unroll
        for (int j = 0; j < 4; ++j) {
            *(LAS v4u*)(tile + ra * 128 + (((4 * hf + j) ^ sa) << 4)) = (v4u){pa[4 * j], pa[4 * j + 1], pa[4 * j + 2], pa[4 * j + 3]};
            *(LAS v4u*)(tile + (ra + 1) * 128 + (((4 * hf + j) ^ sa) << 4)) = (v4u){pb[4 * j], pb[4 * j + 1], pb[4 * j + 2], pb[4 * j + 3]};
        }
    }
    if (HALF < 0) {
#pragma unroll
        for (int jj = 0; jj < 16; ++jj) { const int r = (lane >> 3) + 8 * jj, pc = lane & 7, ch = pc ^ ((r >> 1) & 7);
            const v4u v = *(const LAS v4u*)(tile + r * 128 + (pc << 4));
            *(v4u*)(dst + (size_t)(drow0 + r) * dpitch + k0 + 16 * ch) = v; }
    } else {
#pragma unroll
        for (int jj = 0; jj < 8; ++jj) { const int r = (lane >> 2) + 16 * jj, ch = 4 * HALF + (lane & 3), pc = ch ^ ((r >> 1) & 7);
            const v4u v = *(const LAS v4u*)(tile + r * 128 + (pc << 4));
            *(v4u*)(dst + (size_t)(drow0 + r) * dpitch + k0 + 16 * ch) = v; }
    }
}

struct Args { const float* in[31]; float* out; unsigned char* ws; int ph_lo, ph_hi; };

constexpr int I_IN = 36 * 16, I_A = 8 * 8, I_O = 8 * 16, I_MIX = I_IN + 2 * I_A + I_O, I_13 = 44 * 16, I_2 = 8 * 44, I_M13 = 56 * 8, I_M2 = 8 * 28;
__device__ __forceinline__ void wt_item(const Args& a, int it, int lane, LAS unsigned char* tile) {
    unsigned char* ws = a.ws;
    int r = it;
    if (r < 2 * I_MIX) {
        const int L = r / I_MIX; r -= L * I_MIX;
        unsigned char* wl = ws + (L ? WS_WL1 : WS_WL0);
        if (r < I_IN) {
            const int kb = r / 36, nb = r % 36, u = nb >> 1, bj = nb & 1;
            int col0;
            if (u < 4) col0 = (bj ? 512 : 0) + 128 * u;
            else if (u < 8) col0 = (bj ? 2048 : 1536) + 128 * (u - 4);
            else if (u < 10) col0 = 1024 + 256 * (u - 8) + 128 * bj;
            else col0 = (bj ? 3584 : 2560) + 128 * (u - 10);
            tr_item(L ? a.in[16] : a.in[2], NIN, col0, L ? a.in[15] : a.in[1], (bf16*)(wl + WO_IN), D, nb * 128, 0, kb * 64, lane, tile);
        } else if (r < I_IN + I_A) { r -= I_IN; const int kb = r / 8, nb = r % 8;
            tr_item(L ? a.in[21] : a.in[7], D, nb * 128, nullptr, (bf16*)(wl + WO_AB), D, nb * 128, 0, kb * 64, lane, tile);
        } else if (r < I_IN + 2 * I_A) { r -= I_IN + I_A; const int kb = r / 8, nb = r % 8;
            tr_item(L ? a.in[23] : a.in[9], D, nb * 128, nullptr, (bf16*)(wl + WO_AB), D, nb * 128, DC, kb * 64, lane, tile);
        } else { r -= I_IN + 2 * I_A; const int kb = r / 8, nb = r % 8;
            tr_item(L ? a.in[24] : a.in[10], D, nb * 128, nullptr, (bf16*)(wl + WO_O), D, nb * 128, 0, kb * 64, lane, tile);
        }
        return;
    }
    r -= 2 * I_MIX;
    if (r < I_13) {
        const int kb = r / 44, nb = r % 44, u = nb >> 1, bj = nb & 1;
        tr_item(bj ? a.in[13] : a.in[12], FF0, 128 * u, a.in[11], (bf16*)(ws + WS_WL0 + WO_13), D, nb * 128, 0, kb * 64, lane, tile);
        return;
    }
    r -= I_13;
    if (r < I_2) { const int kb = r / 8, nb = r % 8;
        tr_item(a.in[14], D, nb * 128, nullptr, (bf16*)(ws + WS_WL0 + WO_2), FF0, nb * 128, 0, kb * 64, lane, tile);
        return;
    }
}
constexpr int N_MOE_ITEMS = NE * (I_M13 + I_M2), N_DENSE_ITEMS = 2 * I_MIX + I_13 + I_2;
constexpr int SLOT_Q = 2, SLOT_EXTRA_WGS = 0, N_SLOT_ITEMS = 512 * SLOT_Q + SLOT_EXTRA_WGS * 4;
constexpr int N_MOE_P0 = N_MOE_ITEMS - 3 * N_SLOT_ITEMS;
template <int HALF> __device__ __forceinline__ void moe_item(const Args& a, int r, int lane, LAS unsigned char* tile) {
    unsigned char* ws = a.ws;
    if (r < NE * I_M13) {
        const int e = r / I_M13; r -= e * I_M13;
        const int kb = r / 56, nb = r % 56, u = nb >> 1, bj = nb & 1;
        tr_item_f8<HALF>((bj ? a.in[28] : a.in[27]) + (size_t)e * D * FFE, FFE, 128 * u, a.in[25], ws + WS_WM13 + (size_t)e * 2 * FFE * D, D, nb * 128, kb * 128, lane, tile);
        return;
    }
    r -= NE * I_M13;
    { const int e = r / I_M2; r -= e * I_M2; const int kb = r / 8, nb = r % 8;
      tr_item_f8<HALF>(a.in[29] + (size_t)e * FFE * D, D, nb * 128, nullptr, ws + WS_WM2 + (size_t)e * D * FFE, FFE, nb * 128, kb * 128, lane, tile); }
}
#define MOE_SLOT(s) do { if (G == 256 && bid >= 128) { \
        for (int q_ = 0; q_ < SLOT_Q + ((bid >= 256 - SLOT_EXTRA_WGS) ? 1 : 0); ++q_) { \
            const int it_ = N_MOE_P0 + (s) * N_SLOT_ITEMS + (q_ < SLOT_Q ? q_ * 512 + (bid - 128) * (NWAVES / 2) : SLOT_Q * 512 + (bid - (256 - SLOT_EXTRA_WGS)) * (NWAVES / 2)) + (wave >> 1); \
            if (wave & 1) moe_item<1>(args, it_, lane, lds + RING_OFF + wave * 16384); else moe_item<0>(args, it_, lane, lds + RING_OFF + wave * 16384); } } } while (0)

__global__ void __launch_bounds__(NWAVES * 64, 2) fwd(Args args) {
    extern __shared__ __attribute__((aligned(16))) unsigned char lds_raw[];
    LAS unsigned char* lds = (LAS unsigned char*)lds_raw;
    volatile LAS unsigned* MISC = (volatile LAS unsigned*)(lds + MISC_OFF);
    const int tid = threadIdx.x, lane = tid & 63, wave = __builtin_amdgcn_readfirstlane(tid >> 6);
    const int G = gridDim.x; const int vcu = (G % 8 == 0) ? ((int)blockIdx.x % 8) * (G / 8) + (int)blockIdx.x / 8 : (int)blockIdx.x;
    unsigned char* const ws = args.ws;
    unsigned* const ctl = (unsigned*)(ws + WS_CTL);
    for (int u = tid; u < (LDS_BYTES - LDSCTL_OFF) / 4; u += NWAVES * 64) ((LAS unsigned*)(lds + LDSCTL_OFF))[u] = 0u;
    __syncthreads();
    XcdBarrier bar; bar.bar = ctl + CW_BAR; bar.x = 0; bar.st = nullptr;
    if (!MK_PER_PHASE) bar = xcd_barrier_post(ctl + CW_BAR, MISC + 8);
    if (!MK_PER_PHASE && threadIdx.x == 0) __hip_atomic_store(ctl + CW_XID + blockIdx.x, bar.x + 1u, __ATOMIC_RELAXED, __HIP_MEMORY_SCOPE_AGENT);
    const int lo = args.ph_lo, hi = args.ph_hi;
#ifndef PH_MASK
#define PH_MASK 0xFFFFu
#endif
#define IN(k) (((PH_MASK >> (k)) & 1u) && lo <= (k) && (k) < hi)
#ifndef REP_MASK
#define REP_MASK 0u
#endif
#define REPS(k) (1 + (int)((REP_MASK >> (k)) & 1u))
#define SEAM(k) do { if (IN((k) + 1)) { if (MK_PER_PHASE) { if (tid == 0) __hip_atomic_store(ctl + 0, 0xBADBA0u, __ATOMIC_RELAXED, __HIP_MEMORY_SCOPE_AGENT); } else xcd_barrier(bar); } } while (0)
#define TEAM_CHECK() do { if (!MK_PER_PHASE && threadIdx.x == 0) { unsigned ok_ = 1u, okn_ = 1u; const int pa_ = 8 * ((int)blockIdx.x & 7) + (((int)blockIdx.x >> 3) & 7); for (int j_ = 0; j_ < 4; ++j_) ok_ &= (xb_ld(ctl + CW_XID + ((int)blockIdx.x & 63) + 64 * j_) == bar.x + 1u) ? 1u : 0u; if (pa_ < 63) { const int b0_ = 8 * ((pa_ + 1) & 7) + ((pa_ + 1) >> 3); for (int j_ = 0; j_ < 4; ++j_) okn_ &= (xb_ld(ctl + CW_XID + b0_ + 64 * j_) == bar.x + 1u) ? 1u : 0u; } MISC[12] = ok_; MISC[13] = ok_ & okn_; } } while (0)
#define TEAM_SEAM(k, seq) do { if (IN((k) + 1)) { if (!MK_PER_PHASE && G == 256) team_barrier(ctl + CW_TEAM + 16 * (8 * ((int)blockIdx.x & 7) + (((int)blockIdx.x >> 3) & 7)), 4u * ((unsigned)(seq) + 1u), MISC[12] != 0u, ctl + CW_BAR); else SEAM(k); } } while (0)
#define TEAM_SEAM_NB(k, seq) do { if (IN((k) + 1)) { if (!MK_PER_PHASE && G == 256) { const int pa_ = 8 * ((int)blockIdx.x & 7) + (((int)blockIdx.x >> 3) & 7); team_barrier(ctl + CW_TEAM + 16 * pa_, 4u * ((unsigned)(seq) + 1u), MISC[13] != 0u, ctl + CW_BAR, pa_ > 0 ? ctl + CW_TEAM + 16 * (pa_ - 1) : nullptr); } else SEAM(k); } } while (0)
    const int gw = vcu * NWAVES + wave, NGW = G * NWAVES;
    const int vr = (G == 256) ? 4 * (8 * ((int)blockIdx.x & 7) + (((int)blockIdx.x >> 3) & 7)) + ((int)blockIdx.x >> 6) : vcu;
#define PHASE_PTRS() GAS unsigned char* wsp = (GAS unsigned char*)ws; asm volatile("" : "+s"(wsp)); int bid = (int)blockIdx.x; asm volatile("" : "+s"(bid)); (void)bid; int tidp_ = (int)threadIdx.x; asm volatile("" : "+v"(tidp_)); const int tid = tidp_, lane = tid & 63; (void)tid; (void)lane; float* const ssb = (float*)(wsp + WS_SS); bf16* const XB = (bf16*)(wsp + WS_XB); \
    GAS unsigned char* const pool = wsp + WS_POOL; (void)ssb; (void)XB; (void)pool

#define RSTD_TABLE(pa) do { LAS float* rt_ = (LAS float*)(lds + LDSCTL_OFF + 1024); if (tid < 256) { const f32x4* p_ = (const f32x4*)(ssb + ((size_t)(pa) * 256 + tid) * 16); \
        const f32x4 a_ = p_[0], b_ = p_[1], c_ = p_[2], d_ = p_[3]; const float s_ = (((a_.x + a_.y) + (a_.z + a_.w)) + ((b_.x + b_.y) + (b_.z + b_.w))) + (((c_.x + c_.y) + (c_.z + c_.w)) + ((d_.x + d_.y) + (d_.z + d_.w))); \
        rt_[tid] = __builtin_amdgcn_rsqf(s_ * (1.0f / 1024.0f) + 1e-6f); } __syncthreads(); } while (0)
    const LAS float* const RTAB = (const LAS float*)(lds + LDSCTL_OFF + 1024);

    if (IN(0)) {
        PHASE_PTRS();
        for (int rep_ = 0; rep_ < REPS(0); ++rep_)
        if (G == 256 && N_MOE_P0 >= 2048 && N_MOE_P0 <= 2304) {
            LAS unsigned char* const til = lds + RING_OFF + wave * 16384;
#pragma unroll 1
            for (int st = 0; st < 3; ++st) {
                int kind = 0, idx = 0;
                if (st == 0) { kind = 1; idx = wave * 256 + bid; }
                else if (wave == 0) { kind = (st == 1 && 2048 + bid < N_MOE_P0) ? 1 : 0; idx = 2048 + bid; }
                else { const int d = (wave - 1) * 256 + bid; if (st == 1) { kind = 2; idx = d; } else { kind = (1792 + d < N_DENSE_ITEMS) ? 2 : 0; idx = 1792 + d; } }
                if (kind == 1) moe_item<-1>(args, idx, lane, til); else if (kind == 2) wt_item(args, idx, lane, til);
            }
        } else
        for (int it = gw; it < N_DENSE_ITEMS + N_MOE_P0; it += NGW) { if (it < N_DENSE_ITEMS) wt_item(args, it, lane, lds + RING_OFF + wave * 16384); else moe_item<-1>(args, it - N_DENSE_ITEMS, lane, lds + RING_OFF + wave * 16384); }
        const float* x = args.in[0];
        for (int m0 = gw; m0 < S; m0 += 4 * NGW) {
            f32x4 v[4][4];
#pragma unroll
            for (int b = 0; b < 4; ++b) { const f32x4* xr = (const f32x4*)(x + (size_t)(m0 + b * NGW) * D) + lane;
#pragma unroll
                for (int j = 0; j < 4; ++j) v[b][j] = __builtin_nontemporal_load(xr + 64 * j); }
#pragma unroll
            for (int b = 0; b < 4; ++b) {
                const int m = m0 + b * NGW; float s = 0.f;
#pragma unroll
                for (int j = 0; j < 4; ++j) s += (v[b][j].x * v[b][j].x + v[b][j].y * v[b][j].y) + (v[b][j].z * v[b][j].z + v[b][j].w * v[b][j].w);
                s = wave_sum(s);
                v2u* o8 = (v2u*)(XB + (size_t)m * D) + lane;
#pragma unroll
                for (int j = 0; j < 4; ++j) { v2u w; w.x = cvt_pk_bf16(v[b][j].x, v[b][j].y); w.y = cvt_pk_bf16(v[b][j].z, v[b][j].w); o8[64 * j] = w; }
                if (lane < 16) ssb[(size_t)m * 16 + lane] = (lane == 0) ? s : 0.f;
            }
        }
        SEAM(0);
    }

    for (int layer = 0; layer < 2; ++layer) {
        const int pb = 1 + 6 * layer;
        if (IN(pb)) {
            PHASE_PTRS(); GAS unsigned char* const wl = wsp + (layer ? WS_WL1 : WS_WL0); (void)wl;
            pg8::Gemm g{XB, (const bf16*)(wl + WO_IN), D, D};
            int pa0; { pg8::StaticOrder S0; S0.init(S / 256, 10, G, bid, 0); pg8::Unit u0; pa0 = S0.next(0, u0) ? u0.pa : 0; }
            if (layer == 0) TEAM_CHECK();
            RSTD_TABLE(pa0);
            for (int rep_ = 0; rep_ < REPS(1); ++rep_)
            { pg8::StaticOrder So; So.init(S / 256, 10, G, bid, 0);
              pg8::EpiG1<0> E{ssb, (bf16*)(pool + (layer ? PO_A1 : PO_A)), (bf16*)(pool + (layer ? PO_V1 : PO_V)), (bf16*)(pool + PO_SB), (bf16*)(pool + PO_R), (bf16*)(pool + PO_G), RTAB, pa0};
              pg8::gemm_phase<pg8::EpiG1<0>, pg8::StaticOrder, true, true>(lds + RING_OFF, g, So, E); }
            for (int rep_ = 0; rep_ < REPS(20); ++rep_)
            { pg8::StaticOrder So; So.init(S / 256, 8, G, bid, 10);
              pg8::EpiG1<1> E{ssb, (bf16*)(pool + (layer ? PO_A1 : PO_A)), (bf16*)(pool + (layer ? PO_V1 : PO_V)), (bf16*)(pool + PO_SB), (bf16*)(pool + PO_R), (bf16*)(pool + PO_G), RTAB, pa0};
              pg8::gemm_phase<pg8::EpiG1<1>, pg8::StaticOrder, true, true>(lds + RING_OFF, g, So, E); }
            if (layer == 0) MOE_SLOT(0); else MOE_SLOT(2);
            TEAM_SEAM_NB(pb, layer ? 6 : 0);
        }
        if (IN(pb + 1)) {
            PHASE_PTRS(); GAS unsigned char* const wl = wsp + (layer ? WS_WL1 : WS_WL0); (void)wl;
            const float* conv_a = layer ? args.in[17] : args.in[3]; const float* conv_ab = layer ? args.in[18] : args.in[4];
            const float* ln_g = layer ? args.in[19] : args.in[5]; const float* ln_b = layer ? args.in[20] : args.in[6]; const float* conv_b = layer ? args.in[22] : args.in[8];
            const bf16* abuf = (const bf16*)(pool + (layer ? PO_A1 : PO_A)); const bf16* vbuf = (const bf16*)(pool + (layer ? PO_V1 : PO_V)); const bf16* sbuf = (const bf16*)(pool + PO_SB); bf16* A2 = (bf16*)(pool + PO_A2);
            LAS float* cv = (LAS float*)(lds + RING_OFF);
            LAS float* wl31 = (LAS float*)(lds + RING_OFF + 65536);
            const int cq = tid & 127, oct = tid >> 7;
            for (int idx = tid; idx < 31 * DC / 4; idx += NWAVES * 64) ((LAS f32x4*)wl31)[idx] = ((const f32x4*)conv_a)[idx];
            f32x4 wb[3];
#pragma unroll
            for (int j = 0; j < 3; ++j) wb[j] = *(const f32x4*)(conv_b + j * DC + 4 * cq);
            const f32x4 cbias = *(const f32x4*)(conv_ab + 4 * cq);
            const f32x4 g0 = *(const f32x4*)(ln_g + 4 * lane), g1 = *(const f32x4*)(ln_g + 256 + 4 * lane), b0 = *(const f32x4*)(ln_b + 4 * lane), b1 = *(const f32x4*)(ln_b + 256 + 4 * lane);
            __syncthreads();
            int ctile0 = vcu, cstep = G;
            if (G == 256) { ctile0 = 8 * (8 * (bid & 7) + ((bid >> 3) & 7)) + 2 * (bid >> 6); cstep = 1; }
            for (int rep_ = 0; rep_ < REPS(2); ++rep_)
            for (int tile = ctile0, tcount = 0; (G == 256) ? (tcount < 2) : (tile < S / 32); tile += cstep, ++tcount) {
                const int tb = tile * 32 + oct * 8;
                {
                    v2u in[38];
#pragma unroll
                    for (int i = 0; i < 38; ++i) { const int r = tb - 30 + i; in[i] = (r >= 0) ? *(const v2u*)(abuf + (size_t)r * DC + 4 * cq) : (v2u){0u, 0u}; }
                    v2u vin[10], sv[8];
#pragma unroll
                    for (int i = 0; i < 10; ++i) { const int r = tb - 2 + i; vin[i] = (r >= 0) ? *(const v2u*)(vbuf + (size_t)r * DC + 4 * cq) : (v2u){0u, 0u}; }
#pragma unroll
                    for (int o = 0; o < 8; ++o) sv[o] = *(const v2u*)(sbuf + (size_t)(tb + o) * DC + 4 * cq);
                    f32x4 acc8[8];
#pragma unroll
                    for (int o = 0; o < 8; ++o) acc8[o] = cbias;
#pragma unroll
                    for (int j = 0; j < 31; ++j) { const f32x4 w = *(const LAS f32x4*)(wl31 + j * DC + 4 * cq);
#pragma unroll
                        for (int o = 0; o < 8; ++o) { const v2u x = in[o + j]; acc8[o] += (f32x4){bflo(x.x), bfhi(x.x), bflo(x.y), bfhi(x.y)} * w; } }
#pragma unroll
                    for (int o = 0; o < 8; ++o) *(LAS f32x4*)(cv + (oct * 8 + o) * DC + 4 * cq) = acc8[o];
#pragma unroll
                    for (int o = 0; o < 8; ++o) {
                        f32x4 u = (f32x4){0.f, 0.f, 0.f, 0.f};
#pragma unroll
                        for (int j = 0; j < 3; ++j) { const v2u x = vin[o + j]; u += (f32x4){bflo(x.x), bfhi(x.x), bflo(x.y), bfhi(x.y)} * wb[j]; }
                        const v2u s = sv[o]; v2u w; w.x = cvt_pk_bf16(bflo(s.x) * u.x, bfhi(s.x) * u.y); w.y = cvt_pk_bf16(bflo(s.y) * u.z, bfhi(s.y) * u.w);
                        *(v2u*)(A2 + (size_t)(tb + o) * D + DC + 4 * cq) = w;
                    }
                }
                __syncthreads();
#pragma unroll
                for (int tk = 0; tk < 4; ++tk) {
                    const int t = wave * 4 + tk;
                    const f32x4 xa = *(const LAS f32x4*)(cv + t * DC + 4 * lane), xc = *(const LAS f32x4*)(cv + t * DC + 256 + 4 * lane);
                    const float mean = wave_sum((xa.x + xa.y) + (xa.z + xa.w) + (xc.x + xc.y) + (xc.z + xc.w)) * (1.f / DC);
                    const f32x4 da = xa - mean, dc = xc - mean;
                    const float var = wave_sum((da.x * da.x + da.y * da.y) + (da.z * da.z + da.w * da.w) + (dc.x * dc.x + dc.y * dc.y) + (dc.z * dc.z + dc.w * dc.w)) * (1.f / DC);
                    const float rstd = __builtin_amdgcn_rsqf(var + LNC_EPS);
                    f32x4 ya = da * rstd * g0 + b0, yc = dc * rstd * g1 + b1;
#pragma unroll
                    for (int j = 0; j < 4; ++j) { ya[j] = ya[j] * sigmoid_f(ya[j]); yc[j] = yc[j] * sigmoid_f(yc[j]); }
                    bf16* orow = A2 + (size_t)(tile * 32 + t) * D;
                    v2u w; w.x = cvt_pk_bf16(ya.x, ya.y); w.y = cvt_pk_bf16(ya.z, ya.w); *(v2u*)(orow + 4 * lane) = w;
                    w.x = cvt_pk_bf16(yc.x, yc.y); w.y = cvt_pk_bf16(yc.z, yc.w); *(v2u*)(orow + 256 + 4 * lane) = w;
                }
                __syncthreads();
            }
            TEAM_SEAM(pb + 1, layer ? 7 : 1);
        }
        if (IN(pb + 2)) {
            PHASE_PTRS(); GAS unsigned char* const wl = wsp + (layer ? WS_WL1 : WS_WL0); (void)wl;
            pg8::StaticOrder So; So.init(S / 256, D / 256, G, bid);
            pg8::Gemm g{(const bf16*)(pool + PO_A2), (const bf16*)(wl + WO_AB), D, D};
            pg8::EpiG2 E{(const bf16*)(pool + PO_R), (const bf16*)(pool + PO_G), (bf16*)(wsp + WS_MG)};
            for (int rep_ = 0; rep_ < REPS(3); ++rep_)
            pg8::gemm_phase<pg8::EpiG2, pg8::StaticOrder, true, true>(lds + RING_OFF, g, So, E);
            TEAM_SEAM(pb + 2, layer ? 8 : 2);
        }
        if (IN(pb + 3)) {
            PHASE_PTRS(); GAS unsigned char* const wl = wsp + (layer ? WS_WL1 : WS_WL0); (void)wl;
            pg8::Gemm g{(const bf16*)(wsp + WS_MG), (const bf16*)(wl + WO_O), D, D}; pg8::StaticOrder So; So.init(S / 256, D / 256, G, bid);
            if (layer == 0) { pg8::EpiRes<true, true> E{args.in[0], XB, ssb};
                pg8::gemm_phase<pg8::EpiRes<true, true>, pg8::StaticOrder, true, true>(lds + RING_OFF, g, So, E); }
            else { pg8::EpiRes<false, false> E{nullptr, XB, ssb};
                pg8::gemm_phase<pg8::EpiRes<false, false>, pg8::StaticOrder, true, true>(lds + RING_OFF, g, So, E); }
            TEAM_SEAM(pb + 3, layer ? 9 : 3);
        }
        if (layer == 0) {
            if (IN(5)) {
                PHASE_PTRS();
                pg8::Gemm g{XB, (const bf16*)(wsp + WS_WL0 + WO_13), D, D}; pg8::StaticOrder So; So.init(S / 256, 2 * FF0 / 256, G, bid);
                int pa0; { pg8::Unit u0; pa0 = So.next(0, u0) ? u0.pa : 0; }
                RSTD_TABLE(pa0);
                pg8::EpiUp<false> E{ssb, (bf16*)(pool + PO_HID), FF0, RTAB, pa0};
                for (int rep_ = 0; rep_ < REPS(5); ++rep_)
                pg8::gemm_phase<pg8::EpiUp<false>, pg8::StaticOrder, true, true>(lds + RING_OFF, g, So, E);
                MOE_SLOT(1);
                TEAM_SEAM(5, 4);
            }
            if (IN(6)) {
                PHASE_PTRS();
                pg8::Gemm g{(const bf16*)(pool + PO_HID), (const bf16*)(wsp + WS_WL0 + WO_2), FF0, FF0}; pg8::StaticOrder So; So.init(S / 256, D / 256, G, bid);
                pg8::EpiRes<true, false> E{nullptr, XB, ssb};
                pg8::gemm_phase<pg8::EpiRes<true, false>, pg8::StaticOrder, true, true>(lds + RING_OFF, g, So, E);
                TEAM_SEAM(6, 5);
            }
        }
    }

#define MOE_PTRS() PHASE_PTRS(); unsigned* const tok_e = (unsigned*)(wsp + WS_TOKE); f32x2* const tok_w = (f32x2*)(wsp + WS_TOKW); float* const tok_r = (float*)(wsp + WS_TOKR); v2i* const tok_s = (v2i*)(wsp + WS_TOKS); \
    int* const cntg = (int*)(wsp + WS_CNT); int* const psg = (int*)(wsp + WS_PS); float* const slot_r = (float*)(wsp + WS_SLOTR); float* const slot_w = (float*)(wsp + WS_SLOTW); \
    unsigned char* const XG = (unsigned char*)(wsp + WS_XG); unsigned char* const HC = (unsigned char*)(wsp + WS_HC); unsigned char* const Y = (unsigned char*)(wsp + WS_Y); (void)Y; unsigned char* const PT = (unsigned char*)(wsp + WS_PT); (void)PT; (void)tok_e; (void)tok_w; (void)tok_r; (void)tok_s; (void)cntg; (void)psg; (void)slot_r; (void)slot_w; (void)XG; (void)HC

    if (IN(11)) {
        MOE_PTRS();
        LAS float* rgA = (LAS float*)(lds + RING_OFF);
        LAS float* rgB = rgA + 4096;
        LAS int* hist = (LAS int*)(lds + RING_OFF + 32768);
        const float* router = args.in[26]; const float* g2 = args.in[25];
        v2u xrow[8][4];
#pragma unroll
        for (int b = 0; b < 8; ++b) { const v2u* xr_ = (const v2u*)(XB + (size_t)(vr * 64 + wave * 8 + b) * D) + lane;
#pragma unroll
            for (int j = 0; j < 4; ++j) xrow[b][j] = xr_[64 * j]; }
        { f32x4 rv[4]; float gk[4];
#pragma unroll
          for (int i4 = 0; i4 < 4; ++i4) { const int q = tid + 512 * i4; rv[i4] = ((const f32x4*)router)[q]; gk[i4] = g2[q >> 1]; }
#pragma unroll
          for (int i4 = 0; i4 < 4; ++i4) { const int q = tid + 512 * i4, k = q >> 1, jj = k >> 8, ln = (k & 255) >> 2, ii = k & 3;
              *(LAS f32x4*)(((q & 1) ? rgB : rgA) + ((jj * 4 + ii) * 64 + ln) * 4) = rv[i4] * gk[i4]; } }
        if (tid < 8) hist[tid] = 0;
        __syncthreads();
        float ac[8][8], sqv[8];
#pragma unroll
        for (int b = 0; b < 8; ++b) { sqv[b] = 0.f;
#pragma unroll
            for (int e = 0; e < 8; ++e) ac[b][e] = 0.f; }
#pragma unroll
        for (int j = 0; j < 4; ++j)
#pragma unroll
            for (int i = 0; i < 4; ++i) {
                const f32x4 ra = *(const LAS f32x4*)(rgA + ((j * 4 + i) * 64 + lane) * 4), rb = *(const LAS f32x4*)(rgB + ((j * 4 + i) * 64 + lane) * 4);
#pragma unroll
                for (int b = 0; b < 8; ++b) { const v2u xp = xrow[b][j]; const float xx = (i == 0) ? bflo(xp.x) : (i == 1) ? bfhi(xp.x) : (i == 2) ? bflo(xp.y) : bfhi(xp.y);
                    sqv[b] += xx * xx;
                    ac[b][0] += xx * ra.x; ac[b][1] += xx * ra.y; ac[b][2] += xx * ra.z; ac[b][3] += xx * ra.w; ac[b][4] += xx * rb.x; ac[b][5] += xx * rb.y; ac[b][6] += xx * rb.z; ac[b][7] += xx * rb.w; } }
#pragma unroll
        for (int b = 0; b < 8; ++b) {
            const int t = vr * 64 + wave * 8 + b;
            const float sq = wave_sum(sqv[b]);
            float lg[8];
#pragma unroll
            for (int e = 0; e < 8; ++e) lg[e] = wave_sum(ac[b][e]);
            const float rstd = __builtin_amdgcn_rsqf(sq * (1.f / D) + RMS_EPS);
            int e0 = 0; float l0 = lg[0];
#pragma unroll
            for (int e = 1; e < 8; ++e) if (lg[e] > l0) { l0 = lg[e]; e0 = e; }
            int e1 = -1; float l1 = 0.f;
#pragma unroll
            for (int e = 0; e < 8; ++e) if (e != e0 && (e1 < 0 || lg[e] > l1)) { l1 = lg[e]; e1 = e; }
            const float w0 = 1.0f / (1.0f + __expf((l1 - l0) * rstd)), w1 = 1.0f - w0;
            if (lane == 0) { tok_e[t] = (unsigned)e0 | ((unsigned)e1 << 8); tok_w[t] = (f32x2){w0, w1}; tok_r[t] = rstd; __hip_atomic_fetch_add(&hist[e0], 1, __ATOMIC_RELAXED, __HIP_MEMORY_SCOPE_WORKGROUP); __hip_atomic_fetch_add(&hist[e1], 1, __ATOMIC_RELAXED, __HIP_MEMORY_SCOPE_WORKGROUP); }
        }
        __syncthreads();
        if (tid < 8) cntg[vr * 8 + tid] = hist[tid];
        __syncthreads();
        SEAM(11);
    }
    if (IN(12)) {
        MOE_PTRS();
        LAS int* sh = (LAS int*)(lds + RING_OFF);
        v4u xr8[8][2];
#pragma unroll
        for (int tk = 0; tk < 8; ++tk) { const v4u* xr = (const v4u*)(XB + (size_t)(vr * 64 + wave * 8 + tk) * D) + 2 * lane; xr8[tk][0] = xr[0]; xr8[tk][1] = xr[1]; }
        {
            v4i c0 = (v4i){0, 0, 0, 0}, c1 = c0;
            if (tid < G) { c0 = *(const v4i*)(cntg + tid * 8); c1 = *(const v4i*)(cntg + tid * 8 + 4); }
            const int c[8] = {c0.x, c0.y, c0.z, c0.w, c1.x, c1.y, c1.z, c1.w};
#pragma unroll
            for (int e = 0; e < 8; ++e) { int a = c[e], b = (tid < vr) ? c[e] : 0;
#pragma unroll
                for (int o = 1; o < 64; o <<= 1) { a += __shfl_xor(a, o); b += __shfl_xor(b, o); }
                if (lane == 0) { sh[256 + wave * 16 + e] = a; sh[256 + wave * 16 + 8 + e] = b; } }
        }
        __syncthreads();
        if (tid == 0) { int p = 0;
            for (int e = 0; e < 8; ++e) { int T = 0, P = 0; for (int w = 0; w < NWAVES; ++w) { T += sh[256 + w * 16 + e]; P += sh[256 + w * 16 + 8 + e]; }
                sh[e] = T; sh[16 + e] = p; sh[32 + e] = 256 * p + P; p += (T + 255) >> 8; }
            sh[24] = p;
            if (vr == 0) { for (int e = 0; e < 9; ++e) psg[e] = sh[16 + e]; } }
        __syncthreads();
        if (wave == 0) {
            const int t = vr * 64 + lane; const unsigned ee = tok_e[t]; const int e0 = ee & 255, e1 = ee >> 8; int s0 = 0, s1 = 0;
            const unsigned long long below = (1ull << lane) - 1ull;
#pragma unroll
            for (int e = 0; e < 8; ++e) { const unsigned long long mk = __ballot((e0 == e) || (e1 == e)); const int rank = __popcll(mk & below); const int o = sh[32 + e] + rank; if (e0 == e) s0 = o; if (e1 == e) s1 = o; }
            tok_s[t] = (v2i){s0, s1}; sh[64 + 2 * lane] = s0; sh[64 + 2 * lane + 1] = s1;
            const f32x2 w = tok_w[t]; const float rs = tok_r[t];
            slot_r[s0] = rs; slot_r[s1] = rs; slot_w[s0] = w.x; slot_w[s1] = w.y;
        }
        __syncthreads();
#pragma unroll
        for (int tk = 0; tk < 8; ++tk) {
            const int i = wave * 8 + tk; const int s0 = sh[64 + 2 * i], s1 = sh[64 + 2 * i + 1];
            const v4u a = xr8[tk][0], b = xr8[tk][1]; v4u w;
            w.x = pg8::pk4_fp8(bflo(a.x), bfhi(a.x), bflo(a.y), bfhi(a.y)); w.y = pg8::pk4_fp8(bflo(a.z), bfhi(a.z), bflo(a.w), bfhi(a.w));
            w.z = pg8::pk4_fp8(bflo(b.x), bfhi(b.x), bflo(b.y), bfhi(b.y)); w.w = pg8::pk4_fp8(bflo(b.z), bfhi(b.z), bflo(b.w), bfhi(b.w));
            *((v4u*)(XG + (size_t)s0 * D) + lane) = w; *((v4u*)(XG + (size_t)s1 * D) + lane) = w;
        }
        for (int e = 0; e < 8; ++e) {
            const int tot = sh[e], base = 256 * sh[16 + e] + tot, npad = 256 * (sh[16 + e + 1] - sh[16 + e]) - tot;
            for (int pr = vcu; pr < npad; pr += G) { const int row = base + pr;
                if (tid < 64) ((v4u*)(XG + (size_t)row * D))[tid] = (v4u){0u, 0u, 0u, 0u};
                if (tid == 0) { slot_r[row] = 0.f; slot_w[row] = 0.f; } }
        }
        __syncthreads();
        SEAM(12);
    }
    {
        const int pu = 13;
        if (IN(pu) || IN(pu + 1)) {
            MOE_PTRS();
            int psv = (lane < 9) ? psg[lane] : 0;
            pg8::MoeOrder<true> Su; pg8::MoeOrder<false> Sd;
#pragma unroll
            for (int e = 0; e < 9; ++e) { Su.ps[e] = __builtin_amdgcn_readlane(psv, e); Sd.ps[e] = Su.ps[e]; }
            const int NP = Su.ps[8];
            if (IN(pu)) {
                Su.p_lo = 0; Su.np = NP; Su.nN = 2 * FFE / 256; Su.nwg = NP * Su.nN; Su.G = G; Su.c = bid;
                pg8::Gemm g{(const bf16*)XG, (const bf16*)(wsp + WS_WM13), D / 2, D / 2};
                pg8::EpiUp<true> E{slot_r, HC, FFE, nullptr, 0};
                for (int rep_ = 0; rep_ < REPS(pu); ++rep_)
                pg8::gemm_phase<pg8::EpiUp<true>, pg8::MoeOrder<true>, true, true, true>(lds + RING_OFF, g, Su, E);
                SEAM(pu);
            }
            if (IN(pu + 1)) {
                const int npm = NP < pg8::TAIL_P0 ? NP : pg8::TAIL_P0;
                Sd.p_lo = 0; Sd.np = npm; Sd.nN = D / 256; Sd.nwg = npm * Sd.nN; Sd.G = G; Sd.c = bid;
                pg8::MoeTailOrder St; St.ntail = NP - npm; St.G = G; St.c = bid;
#pragma unroll
                for (int e = 0; e < 9; ++e) St.ps[e] = Sd.ps[e];
                for (int rep_ = 0; rep_ < REPS(pu + 1); ++rep_) {
                { pg8::Gemm g{(const bf16*)HC, (const bf16*)(wsp + WS_WM2), FFE / 2, FFE / 2};
                  pg8::EpiDownMoeT<false> E{slot_w, Y};
                  pg8::gemm_phase<pg8::EpiDownMoeT<false>, pg8::MoeOrder<false>, true, true, true>(lds + RING_OFF, g, Sd, E); }
                { pg8::Gemm g{(const bf16*)HC, (const bf16*)(wsp + WS_WM2), 256, FFE / 2};
                  pg8::EpiDownMoeT<true> E{slot_w, PT};
                  pg8::gemm_phase<pg8::EpiDownMoeT<true>, pg8::MoeTailOrder, true, true, true>(lds + RING_OFF, g, St, E); }
                }
                SEAM(pu + 1);
            }
        }
    }
    if (IN(15)) {
        MOE_PTRS();
        const float* gf = args.in[30]; float* out = args.out;
        f32x4 gv[4];
#pragma unroll
        for (int j = 0; j < 4; ++j) gv[j] = *((const f32x4*)gf + lane + 64 * j);
        for (int rep_ = 0; rep_ < REPS(15); ++rep_)
        for (int m0 = gw; m0 < S; m0 += 4 * NGW) {
            v2i sl[4];
#pragma unroll
            for (int b = 0; b < 4; ++b) sl[b] = tok_s[m0 + b * NGW];
            v2u xa[4][4]; unsigned ya[4][2][4];
#pragma unroll
            for (int b = 0; b < 4; ++b) {
                const v2u* xr = (const v2u*)(XB + (size_t)(m0 + b * NGW) * D) + lane;
#pragma unroll
                for (int j = 0; j < 4; ++j) xa[b][j] = xr[64 * j];
#pragma unroll
                for (int q = 0; q < 2; ++q) { const int sq = q ? sl[b].y : sl[b].x; const unsigned* y = (const unsigned*)(Y + (size_t)(sq < pg8::TAIL_P0 * 256 ? sq : 0) * D) + lane;
#pragma unroll
                    for (int j = 0; j < 4; ++j) ya[b][q][j] = y[64 * j]; }
            }
#pragma unroll
            for (int b = 0; b < 4; ++b) {
                const int m = m0 + b * NGW;
                f32x4 v[4]; float s = 0.f;
#pragma unroll
                for (int j = 0; j < 4; ++j) { const v2u a = xa[b][j]; v[j] = (f32x4){bflo(a.x), bfhi(a.x), bflo(a.y), bfhi(a.y)}; }
#pragma unroll
                for (int q = 0; q < 2; ++q) {
                    const int sq = q ? sl[b].y : sl[b].x;
                    if (sq < pg8::TAIL_P0 * 256) {
#pragma unroll
                        for (int j = 0; j < 4; ++j) { const unsigned a = ya[b][q][j]; const f32x2 lo = __builtin_amdgcn_cvt_pk_f32_fp8((int)a, false), hi = __builtin_amdgcn_cvt_pk_f32_fp8((int)a, true);
                            v[j].x += lo.x * pg8::Y8_INV; v[j].y += lo.y * pg8::Y8_INV; v[j].z += hi.x * pg8::Y8_INV; v[j].w += hi.y * pg8::Y8_INV; }
                    } else {
                        const int pl = (sq >> 8) - pg8::TAIL_P0, r = sq & 255;
                        for (int ks = 0; ks < pg8::TAIL_NKS; ++ks) { const unsigned* y = (const unsigned*)(PT + ((size_t)(ks * 8 + pl) * 256 + r) * D) + lane;
#pragma unroll
                            for (int j = 0; j < 4; ++j) { const unsigned a = y[64 * j]; const f32x2 lo = __builtin_amdgcn_cvt_pk_f32_fp8((int)a, false), hi = __builtin_amdgcn_cvt_pk_f32_fp8((int)a, true);
                                v[j].x += lo.x * pg8::Y8_INV; v[j].y += lo.y * pg8::Y8_INV; v[j].z += hi.x * pg8::Y8_INV; v[j].w += hi.y * pg8::Y8_INV; } }
                    }
                }
#pragma unroll
                for (int j = 0; j < 4; ++j) s += (v[j].x * v[j].x + v[j].y * v[j].y) + (v[j].z * v[j].z + v[j].w * v[j].w);
                const float rstd = __builtin_amdgcn_rsqf(wave_sum(s) * (1.f / D) + RMS_EPS);
                f32x4* o = (f32x4*)(out + (size_t)m * D) + lane;
#pragma unroll
                for (int j = 0; j < 4; ++j) o[64 * j] = v[j] * rstd * gv[j];
            }
        }
    }
#undef IN
#undef SEAM
}

constexpr int N_PHASES = 16;
extern "C" void kernel_launch(void* const* d_in, const int* in_sizes, int n_in, void* d_out, int out_size, void* d_ws, size_t ws_size, hipStream_t stream) {
    static int grid = 0;
    if (grid == 0) {
        if (n_in != 31 || in_sizes[0] != S * D || out_size != S * D || ws_size < WS_END) { fprintf(stderr, "kernel_launch: unexpected shapes (n_in %d, in0 %d, out %d, ws %zu < %zu); nothing launched\n", n_in, n_in > 0 ? in_sizes[0] : -1, out_size, ws_size, (size_t)WS_END); grid = -1; return; }
        int dev = 0, cus = 0, per_cu = 0;
        if (hipGetDevice(&dev) != hipSuccess || hipDeviceGetAttribute(&cus, hipDeviceAttributeMultiprocessorCount, dev) != hipSuccess) { grid = -1; return; }
        if (hipFuncSetAttribute((const void*)fwd, hipFuncAttributeMaxDynamicSharedMemorySize, LDS_BYTES) != hipSuccess) { fprintf(stderr, "kernel_launch: hipFuncSetAttribute failed\n"); grid = -1; return; }
        if (hipOccupancyMaxActiveBlocksPerMultiprocessor(&per_cu, (const void*)fwd, NWAVES * 64, LDS_BYTES) != hipSuccess || per_cu < 1) fprintf(stderr, "kernel_launch: occupancy query reports %d workgroups per CU\n", per_cu);
        (void)hipGetLastError();
        grid = cus;
        if (grid > 256) grid = 256;
    }
    if (grid < 0) return;
    if (hipMemsetAsync((char*)d_ws + WS_CTL, 0, CTL_ZERO_BYTES, stream) != hipSuccess) return;
    Args a{};
    for (int i = 0; i < 31; ++i) a.in[i] = (const float*)d_in[i];
    a.out = (float*)d_out; a.ws = (unsigned char*)d_ws;
#if MK_PER_PHASE
    for (int p = 0; p < N_PHASES; ++p) { a.ph_lo = p; a.ph_hi = p + 1; hipLaunchKernelGGL(fwd, dim3(grid), dim3(NWAVES * 64), LDS_BYTES, stream, a); }
#else
    a.ph_lo = 0; a.ph_hi = N_PHASES;
    hipLaunchKernelGGL(fwd, dim3(grid), dim3(NWAVES * 64), LDS_BYTES, stream, a);
#endif
}
```

```cpp
#include <hip/hip_runtime.h>
#include <cstdio>
#include <cstdint>

#ifndef MK_PER_PHASE
#define MK_PER_PHASE 0
#endif

namespace pg8 {
#define PG8_LAS __attribute__((address_space(3)))
#define PG8_GAS __attribute__((address_space(1)))
typedef unsigned short bf16_t;
typedef short bf16x8 __attribute__((ext_vector_type(8)));
typedef float f32x4 __attribute__((ext_vector_type(4)));
typedef unsigned u32x4 __attribute__((ext_vector_type(4)));
typedef unsigned u32x2 __attribute__((ext_vector_type(2)));
typedef int v4i_t __attribute__((ext_vector_type(4)));
typedef int v8i_t __attribute__((ext_vector_type(8)));
constexpr int BM = 256, BK = 64, HALF = 128, HTB = HALF * BK * 2  , STAGE_BYTES = 8 * HTB, NXCD = 8, WGM = 8;

__host__ __device__ __forceinline__ int lds_byte(int r, int c) { const int st = (r >> 4) * 2 + (c >> 5), rr = r & 15, cc = c & 31, ob = rr * 64 + cc * 2; return st * 1024 + (ob ^ (((ob >> 9) & 1) << 5)); }
__host__ __device__ __forceinline__ void stage_rc(int b, int& R, int& C) { const int st = b / 1024, sb = b % 1024, swz = sb ^ (((sb >> 9) & 1) << 5); R = (st >> 1) * 16 + swz / 64; C = (st & 1) * 32 + (swz % 64) / 2; }
__host__ __device__ __forceinline__ int perm32(int rho) { const int n = rho >> 4, i = rho & 15; return 8 * (i >> 2) + 4 * n + (i & 3); }

struct Unit { int pa, pn, bn, po, koff; };
struct NoPre {};
struct Gemm { const bf16_t* A; const bf16_t* Bt; int K, pitch; };

struct StaticOrder {
    int nM, nN, nwg, G, c, pn0;
    __device__ __forceinline__ void init(int nM_, int nN_, int G_, int c_, int pn0_ = 0) { nM = nM_; nN = nN_; nwg = nM * nN; G = G_; c = c_; pn0 = pn0_; }
    __device__ __forceinline__ bool next(int i, Unit& u) const {
        const long L = (long)i * G + c; if (L >= nwg) return false;
        int wgid = (int)L; { const int q = nwg / NXCD, r = nwg % NXCD, xcd = wgid % NXCD, off = wgid / NXCD; wgid = (xcd < r ? xcd * (q + 1) : r * (q + 1) + (xcd - r) * q) + off; }
        const int nig = WGM * nN, gid = wgid / nig, fm = gid * WGM, gsz = (nM - fm) < WGM ? (nM - fm) : WGM;
        u.pa = fm + ((wgid % nig) % gsz); u.pn = pn0 + (wgid % nig) / gsz; u.bn = u.pn; u.po = u.pa; u.koff = 0; return true;
    }
};
template <bool UP> struct MoeOrder {
    int p_lo, np, nN, nwg, G, c; int ps[9];
    __device__ __forceinline__ bool next(int i, Unit& u) const {
        const long L = (long)i * G + c; if (L >= nwg) return false;
        int wgid = (int)L; { const int q = nwg / NXCD, r = nwg % NXCD, xcd = wgid % NXCD, off = wgid / NXCD; wgid = (xcd < r ? xcd * (q + 1) : r * (q + 1) + (xcd - r) * q) + off; }
        const int nig = WGM * nN, gid = wgid / nig, fm = gid * WGM, gsz = (np - fm) < WGM ? (np - fm) : WGM;
        const int pl = fm + ((wgid % nig) % gsz), pn = (wgid % nig) / gsz, p = p_lo + pl;
        int e = 0;
#pragma unroll
        for (int j = 1; j < 8; ++j) e += (ps[j] <= p) ? 1 : 0;
        u.pn = pn; u.bn = e * nN + pn; u.pa = UP ? p : pl; u.po = UP ? pl : p; u.koff = 0; return true;
    }
};

typedef __bf16 bf16v2_t __attribute__((ext_vector_type(2)));
typedef float f32v2_t __attribute__((ext_vector_type(2)));
constexpr int TAIL_P0 = 128, TAIL_NKS = 7;
struct MoeTailOrder {
    int ntail, G, c; int ps[9];
    __device__ __forceinline__ bool next(int i, Unit& u) const {
        const long L = (long)i * G + c; if (L >= (long)ntail * 4 * TAIL_NKS) return false;
        const int ks = (int)L % TAIL_NKS, tile = (int)L / TAIL_NKS, pl = tile >> 2, pn = tile & 3, p = TAIL_P0 + pl;
        int e = 0;
#pragma unroll
        for (int j = 1; j < 8; ++j) e += (ps[j] <= p) ? 1 : 0;
        u.pa = p; u.pn = pn; u.bn = e * 4 + pn; u.po = ks * 8 + pl; u.koff = ks * 512; return true;
    }
};

__device__ __forceinline__ unsigned cvt_pk_bf16(float lo, float hi) { const f32v2_t f = {lo, hi}; const bf16v2_t b = __builtin_convertvector(f, bf16v2_t); return __builtin_bit_cast(unsigned, b); }
__device__ __forceinline__ float bflo(unsigned w) { return __uint_as_float(w << 16); }
__device__ __forceinline__ float bfhi(unsigned w) { return __uint_as_float(w & 0xffff0000u); }
__device__ __forceinline__ float sigmoid_f(float x) { return __builtin_amdgcn_rcpf(1.0f + __builtin_amdgcn_exp2f(-1.4426950408889634f * x)); }
__device__ __forceinline__ u32x4 pack8(const f32x4& a, const f32x4& b) { u32x4 w; w.x = cvt_pk_bf16(a[0], a[1]); w.y = cvt_pk_bf16(a[2], a[3]); w.z = cvt_pk_bf16(b[0], b[1]); w.w = cvt_pk_bf16(b[2], b[3]); return w; }
__device__ __forceinline__ unsigned pk4_fp8_nc(float a, float b, float c, float d) {
    int w = 0; w = __builtin_amdgcn_cvt_pk_fp8_f32(a, b, w, false); w = __builtin_amdgcn_cvt_pk_fp8_f32(c, d, w, true); return (unsigned)w; }
__device__ __forceinline__ unsigned pk4_fp8(float a, float b, float c, float d) {
    a = __builtin_amdgcn_fmed3f(a, -448.f, 448.f); b = __builtin_amdgcn_fmed3f(b, -448.f, 448.f); c = __builtin_amdgcn_fmed3f(c, -448.f, 448.f); d = __builtin_amdgcn_fmed3f(d, -448.f, 448.f);
    int w = 0; w = __builtin_amdgcn_cvt_pk_fp8_f32(a, b, w, false); w = __builtin_amdgcn_cvt_pk_fp8_f32(c, d, w, true); return (unsigned)w; }
__device__ __forceinline__ void unpack8(const u32x4& w, f32x4& a, f32x4& b) { a[0] = bflo(w.x); a[1] = bfhi(w.x); a[2] = bflo(w.y); a[3] = bfhi(w.y); b[0] = bflo(w.z); b[1] = bfhi(w.z); b[2] = bflo(w.w); b[3] = bfhi(w.w); }
__device__ __forceinline__ void rows_rstd(const float* ss, int row0, int fq, float (&rs)[2][4]) {
    f32x4 pv[2][4];
#pragma unroll
    for (int ai = 0; ai < 2; ++ai)
#pragma unroll
        for (int m = 0; m < 4; ++m) pv[ai][m] = *(const f32x4*)(ss + (size_t)(row0 + ai * HALF + m * 16) * 16 + 4 * fq);
#pragma unroll
    for (int ai = 0; ai < 2; ++ai)
#pragma unroll
        for (int m = 0; m < 4; ++m) { const f32x4 v = pv[ai][m]; float s = (v[0] + v[1]) + (v[2] + v[3]); s += __shfl_xor(s, 16); s += __shfl_xor(s, 32); rs[ai][m] = __builtin_amdgcn_rsqf(s * (1.0f / 1024.0f) + 1e-6f); }
}

__device__ __forceinline__ void rows_rstd_lds(const PG8_LAS float* tab, int pa0, const float* ss, const Unit& u, int wr, int fr, int fq, float (&rs)[2][4]) {
    if (u.po == pa0) {
#pragma unroll
        for (int ai = 0; ai < 2; ++ai)
#pragma unroll
            for (int m = 0; m < 4; ++m) rs[ai][m] = tab[wr * 64 + fr + ai * HALF + m * 16];
    } else rows_rstd(ss, u.po * BM + wr * 64 + fr, fq, rs);
}

template <int PART> struct EpiG1 {
    static constexpr bool HAS_MID = false, ACC_INIT = false;
    const float* ss; bf16_t *a, *v, *sb, *R, *Gt; const PG8_LAS float* rtab; int pa0;
    typedef NoPre Pre; __device__ __forceinline__ void pre(NoPre&, const Unit&, int, int) const {}
    __device__ __forceinline__ void mid(f32x4 (&)[2][2][4][2], const Unit&, int, int, int, int) const {}
    __device__ __forceinline__ void operator()(const f32x4 (&acc)[2][2][4][2], const Unit& u, int wr, int wc, int fr, int fq, const NoPre&) const {
        const int row0 = u.po * BM + wr * 64 + fr, cw = wc * 32 + 8 * fq, pn = u.pn;
        float rsv[2][4]; rows_rstd_lds(rtab, pa0, ss, u, wr, fr, fq, rsv);
#pragma unroll
        for (int ai = 0; ai < 2; ++ai)
#pragma unroll
            for (int m = 0; m < 4; ++m) {
                const int row = row0 + ai * HALF + m * 16;
                const float rs = rsv[ai][m];
                const float rsn = rs * -1.4426950408889634f, rs2 = rs * rs, rinv = __builtin_amdgcn_rcpf(rs);
                if (PART == 0 && pn < 4) {
                    f32x4 o[2];
#pragma unroll
                    for (int hh = 0; hh < 2; ++hh)
#pragma unroll
                        for (int j = 0; j < 4; j += 2) { const f32x4& a1 = acc[ai][0][m][hh]; const f32x4& a2 = acc[ai][1][m][hh];
                            const f32v2_t av = {a1[j], a1[j + 1]}, gv = {a2[j], a2[j + 1]}; const f32v2_t pe = gv * rsn;
                            f32v2_t e; e.x = __builtin_amdgcn_exp2f(pe.x); e.y = __builtin_amdgcn_exp2f(pe.y); const f32v2_t d = e * rinv + rinv;
                            f32v2_t r; r.x = __builtin_amdgcn_rcpf(d.x); r.y = __builtin_amdgcn_rcpf(d.y); const f32v2_t ov = av * r; o[hh][j] = ov.x; o[hh][j + 1] = ov.y; }
                    *(u32x4*)(a + (size_t)row * 512 + pn * 128 + cw) = pack8(o[0], o[1]);
                } else if (PART == 0 && pn < 8) {
                    *(u32x4*)(v + (size_t)row * 512 + (pn - 4) * 128 + cw) = pack8((acc[ai][0][m][0] * acc[ai][1][m][0]) * rs2, (acc[ai][0][m][1] * acc[ai][1][m][1]) * rs2);
                } else if (PART == 0) {
                    bf16_t* d = sb + (size_t)row * 512 + (pn - 8) * 256 + cw;
                    *(u32x4*)d = pack8(acc[ai][0][m][0] * rs, acc[ai][0][m][1] * rs); *(u32x4*)(d + 128) = pack8(acc[ai][1][m][0] * rs, acc[ai][1][m][1] * rs);
                } else {
                    f32x4 rr[2], gg[2];
#pragma unroll
                    for (int hh = 0; hh < 2; ++hh)
#pragma unroll
                        for (int j = 0; j < 4; j += 2) { const f32x4& a1 = acc[ai][0][m][hh]; const f32x4& a2 = acc[ai][1][m][hh];
                            const f32v2_t pa = (f32v2_t){a1[j], a1[j + 1]} * rsn, pb = (f32v2_t){a2[j], a2[j + 1]} * rsn;
                            f32v2_t ea, eb; ea.x = __builtin_amdgcn_exp2f(pa.x); ea.y = __builtin_amdgcn_exp2f(pa.y); eb.x = __builtin_amdgcn_exp2f(pb.x); eb.y = __builtin_amdgcn_exp2f(pb.y);
                            const f32v2_t da = ea + 1.0f, db = eb + 1.0f;
                            f32v2_t ia, ib; ia.x = __builtin_amdgcn_rcpf(da.x); ia.y = __builtin_amdgcn_rcpf(da.y); ib.x = __builtin_amdgcn_rcpf(db.x); ib.y = __builtin_amdgcn_rcpf(db.y);
                            const f32v2_t rv = db * ia; rr[hh][j] = rv.x; rr[hh][j + 1] = rv.y; gg[hh][j] = ib.x; gg[hh][j + 1] = ib.y; }
                    const size_t o = (size_t)row * 1024 + (pn - 10) * 128 + cw;
                    *(u32x4*)(R + o) = pack8(rr[0], rr[1]); *(u32x4*)(Gt + o) = pack8(gg[0], gg[1]);
                }
            }
    }
};
struct EpiG2 {
    static constexpr bool HAS_MID = true, ACC_INIT = false;
    const bf16_t *R, *Gt; bf16_t* out;
    typedef NoPre Pre; __device__ __forceinline__ void pre(NoPre&, const Unit&, int, int) const {}
    __device__ __forceinline__ void mid(f32x4 (&acc)[2][2][4][2], const Unit& u, int wr, int wc, int fr, int fq) const {
        int po_ = u.po; asm volatile("" : "+s"(po_));
        const int row0 = po_ * BM + wr * 64 + fr, cw = u.pn * BM + wc * 32 + 8 * fq;
        u32x4 gv[2][4][2];
        unsigned ro[8];
#pragma unroll
        for (int r = 0; r < 8; ++r) ro[r] = (unsigned)(((row0 + (r >> 2) * HALF + (r & 3) * 16) * 1024 + cw) * 2);
        asm volatile(
            "global_load_dwordx4 %0, %16, %24\n\t"
            "global_load_dwordx4 %1, %16, %24 offset:256\n\t"
            "global_load_dwordx4 %2, %17, %24\n\t"
            "global_load_dwordx4 %3, %17, %24 offset:256\n\t"
            "global_load_dwordx4 %4, %18, %24\n\t"
            "global_load_dwordx4 %5, %18, %24 offset:256\n\t"
            "global_load_dwordx4 %6, %19, %24\n\t"
            "global_load_dwordx4 %7, %19, %24 offset:256\n\t"
            "global_load_dwordx4 %8, %20, %24\n\t"
            "global_load_dwordx4 %9, %20, %24 offset:256\n\t"
            "global_load_dwordx4 %10, %21, %24\n\t"
            "global_load_dwordx4 %11, %21, %24 offset:256\n\t"
            "global_load_dwordx4 %12, %22, %24\n\t"
            "global_load_dwordx4 %13, %22, %24 offset:256\n\t"
            "global_load_dwordx4 %14, %23, %24\n\t"
            "global_load_dwordx4 %15, %23, %24 offset:256\n\t"
            "s_waitcnt vmcnt(0)"
            : "=&v"(gv[0][0][0]), "=&v"(gv[0][0][1]), "=&v"(gv[0][1][0]), "=&v"(gv[0][1][1]), "=&v"(gv[0][2][0]), "=&v"(gv[0][2][1]), "=&v"(gv[0][3][0]), "=&v"(gv[0][3][1]), "=&v"(gv[1][0][0]), "=&v"(gv[1][0][1]), "=&v"(gv[1][1][0]), "=&v"(gv[1][1][1]), "=&v"(gv[1][2][0]), "=&v"(gv[1][2][1]), "=&v"(gv[1][3][0]), "=&v"(gv[1][3][1])
            : "v"(ro[0]), "v"(ro[1]), "v"(ro[2]), "v"(ro[3]), "v"(ro[4]), "v"(ro[5]), "v"(ro[6]), "v"(ro[7]), "s"(R) : "memory");
#pragma unroll
        for (int ai = 0; ai < 2; ++ai)
#pragma unroll
            for (int m = 0; m < 4; ++m)
#pragma unroll
                for (int bj = 0; bj < 2; ++bj) { f32x4 g0, g1; unpack8(gv[ai][m][bj], g0, g1); acc[ai][bj][m][0] *= g0; acc[ai][bj][m][1] *= g1; }
        asm volatile("" ::: "memory");
    }
    __device__ __forceinline__ void operator()(const f32x4 (&acc)[2][2][4][2], const Unit& u, int wr, int wc, int fr, int fq, const NoPre&) const {
        int po_ = u.po; asm volatile("" : "+s"(po_));
        const int row0 = po_ * BM + wr * 64 + fr, cw = u.pn * BM + wc * 32 + 8 * fq;
        u32x4 gv[2][4][2];
#pragma unroll
        for (int ai = 0; ai < 2; ++ai)
#pragma unroll
            for (int m = 0; m < 4; ++m)
#pragma unroll
                for (int bj = 0; bj < 2; ++bj) gv[ai][m][bj] = *(const u32x4*)(Gt + (size_t)(row0 + ai * HALF + m * 16) * 1024 + cw + bj * HALF);
#pragma unroll
        for (int ai = 0; ai < 2; ++ai)
#pragma unroll
            for (int m = 0; m < 4; ++m)
#pragma unroll
                for (int bj = 0; bj < 2; ++bj) { f32x4 g0, g1; unpack8(gv[ai][m][bj], g0, g1);
                    *(u32x4*)(out + (size_t)(row0 + ai * HALF + m * 16) * 1024 + cw + bj * HALF) = pack8(acc[ai][bj][m][0] * g0, acc[ai][bj][m][1] * g1); }
    }
};
template <bool AUX, bool XF32> struct EpiRes {
    static constexpr bool HAS_MID = false, ACC_INIT = true;
    const float* xin; bf16_t* xb; float* ss;
    typedef NoPre Pre; __device__ __forceinline__ void pre(NoPre&, const Unit&, int, int) const {}
    __device__ __forceinline__ void mid(f32x4 (&)[2][2][4][2], const Unit&, int, int, int, int) const {}
    __device__ __forceinline__ void init(f32x4 (&acc)[2][2][4][2], const Unit& u, int wr, int wc, int fr, int fq) const {
        const int row0 = u.po * BM + wr * 64 + fr, cw = u.pn * BM + wc * 32 + 8 * fq;
#pragma unroll
        for (int ai = 0; ai < 2; ++ai)
#pragma unroll
            for (int m = 0; m < 4; ++m)
#pragma unroll
                for (int bj = 0; bj < 2; ++bj) { const size_t o = (size_t)(row0 + ai * HALF + m * 16) * 1024 + cw + bj * HALF;
                    if (XF32) { acc[ai][bj][m][0] = *(const f32x4*)(xin + o); acc[ai][bj][m][1] = *(const f32x4*)(xin + o + 4); }
                    else unpack8(*(const u32x4*)(xb + o), acc[ai][bj][m][0], acc[ai][bj][m][1]); }
    }
    __device__ __forceinline__ void operator()(const f32x4 (&acc)[2][2][4][2], const Unit& u, int wr, int wc, int fr, int fq, const NoPre&) const {
        const int row0 = u.po * BM + wr * 64 + fr, cw = u.pn * BM + wc * 32 + 8 * fq;
#pragma unroll
        for (int ai = 0; ai < 2; ++ai)
#pragma unroll
            for (int m = 0; m < 4; ++m) {
                const int row = row0 + ai * HALF + m * 16; const size_t o = (size_t)row * 1024 + cw; float q = 0.f;
#pragma unroll
                for (int bj = 0; bj < 2; ++bj) {
                    const f32x4 o0 = acc[ai][bj][m][0], o1 = acc[ai][bj][m][1];
                    if (AUX) q += (o0[0] * o0[0] + o0[1] * o0[1]) + (o0[2] * o0[2] + o0[3] * o0[3]) + (o1[0] * o1[0] + o1[1] * o1[1]) + (o1[2] * o1[2] + o1[3] * o1[3]);
                    *(u32x4*)(xb + o + bj * HALF) = pack8(o0, o1);
                }
                if (AUX) { q += __shfl_xor(q, 16); q += __shfl_xor(q, 32); if (fq == 0) ss[(size_t)row * 16 + u.pn * 4 + wc] = q; }
            }
    }
};
constexpr float F8_WSCALE = 64.0f, F8_WINV = 1.0f / 64.0f;
template <bool MOE> struct EpiUp {
    static constexpr bool HAS_MID = false, ACC_INIT = false;
    const float* rsrc; void* hid; int ld; const PG8_LAS float* rtab; int pa0;
    struct Pre { float rs[2][4]; };
    __device__ __forceinline__ void pre(Pre& pf, const Unit& u, int wr, int fr) const {
        if (MOE) { const int row0 = u.po * BM + wr * 64 + fr;
#pragma unroll
            for (int ai = 0; ai < 2; ++ai)
#pragma unroll
                for (int m = 0; m < 4; ++m) pf.rs[ai][m] = rsrc[row0 + ai * HALF + m * 16]; } }
    __device__ __forceinline__ void mid(f32x4 (&)[2][2][4][2], const Unit&, int, int, int, int) const {}
    __device__ __forceinline__ void operator()(const f32x4 (&acc)[2][2][4][2], const Unit& u, int wr, int wc, int fr, int fq, const Pre& pf) const {
        const int row0 = u.po * BM + wr * 64 + fr, cw = u.pn * HALF + wc * 32 + 8 * fq;
        float rsv[2][4];
        if (MOE) {
#pragma unroll
            for (int ai = 0; ai < 2; ++ai)
#pragma unroll
                for (int m = 0; m < 4; ++m) rsv[ai][m] = pf.rs[ai][m] * F8_WINV;
        } else rows_rstd_lds(rtab, pa0, rsrc, u, wr, fr, fq, rsv);
#pragma unroll
        for (int ai = 0; ai < 2; ++ai)
#pragma unroll
            for (int m = 0; m < 4; ++m) {
                const int row = row0 + ai * HALF + m * 16;
                const float rs = rsv[ai][m];
                const float rsn = rs * -1.4426950408889634f, kinv = __builtin_amdgcn_rcpf(rs * rs);
                f32x4 o0, o1;
#pragma unroll
                for (int hh = 0; hh < 2; ++hh)
#pragma unroll
                    for (int j = 0; j < 4; j += 2) {
                        const f32x4& a1 = acc[ai][0][m][hh]; const f32x4& a3 = acc[ai][1][m][hh];
                        const f32v2_t av = {a1[j], a1[j + 1]}, bv = {a3[j], a3[j + 1]};
                        const f32v2_t pe = av * rsn, pq = av * bv;
                        f32v2_t e; e.x = __builtin_amdgcn_exp2f(pe.x); e.y = __builtin_amdgcn_exp2f(pe.y);
                        const f32v2_t d = e * kinv + kinv; f32v2_t r; r.x = __builtin_amdgcn_rcpf(d.x); r.y = __builtin_amdgcn_rcpf(d.y);
                        const f32v2_t o = pq * r;
                        if (hh == 0) { o0[j] = o.x; o0[j + 1] = o.y; } else { o1[j] = o.x; o1[j + 1] = o.y; }
                    }
                if (MOE) { u32x2 w; w.x = pk4_fp8_nc(o0[0], o0[1], o0[2], o0[3]); w.y = pk4_fp8_nc(o1[0], o1[1], o1[2], o1[3]); *(u32x2*)((unsigned char*)hid + (size_t)row * ld + cw) = w; }
                else *(u32x4*)((bf16_t*)hid + (size_t)row * ld + cw) = pack8(o0, o1);
            }
    }
};
constexpr float Y8_SCALE = 16.0f, Y8_INV = 1.0f / 16.0f;
template <bool TAIL> struct EpiDownMoeT {
    static constexpr bool HAS_MID = false, ACC_INIT = false;
    const float* w; unsigned char* Y;
    struct Pre { float ws[2][4]; };
    __device__ __forceinline__ void pre(Pre& pf, const Unit& u, int wr, int fr) const {
        const int row0 = u.po * BM + wr * 64 + fr;
#pragma unroll
        for (int ai = 0; ai < 2; ++ai)
#pragma unroll
            for (int m = 0; m < 4; ++m) { const int row = row0 + ai * HALF + m * 16; pf.ws[ai][m] = w[TAIL ? row - (u.po - (u.po & 7)) * BM + TAIL_P0 * BM : row]; } }
    __device__ __forceinline__ void mid(f32x4 (&)[2][2][4][2], const Unit&, int, int, int, int) const {}
    __device__ __forceinline__ void operator()(const f32x4 (&acc)[2][2][4][2], const Unit& u, int wr, int wc, int fr, int fq, const Pre& pf) const {
        const int row0 = u.po * BM + wr * 64 + fr, cw = u.pn * BM + wc * 32 + 8 * fq;
#pragma unroll
        for (int ai = 0; ai < 2; ++ai)
#pragma unroll
            for (int m = 0; m < 4; ++m) {
                const int row = row0 + ai * HALF + m * 16; const float ws = pf.ws[ai][m] * (F8_WINV * Y8_SCALE); const size_t o = (size_t)row * 1024 + cw;
#pragma unroll
                for (int bj = 0; bj < 2; ++bj) { const f32x4 v0 = acc[ai][bj][m][0] * ws, v1 = acc[ai][bj][m][1] * ws; u32x2 pk; pk.x = pk4_fp8_nc(v0[0], v0[1], v0[2], v0[3]); pk.y = pk4_fp8_nc(v1[0], v1[1], v1[2], v1[3]); *(u32x2*)(Y + o + bj * HALF) = pk; }
            }
    }
};

template <class Epi, class Sched, bool ALIGN_EPI = false, bool SP2 = false, bool F8 = false>
__device__ __forceinline__ void gemm_phase(PG8_LAS unsigned char* lds, const Gemm g, const Sched& S, const Epi& E) {
    int tid_ = threadIdx.x; asm volatile("" : "+v"(tid_));
    const int tid = tid_, wid = __builtin_amdgcn_readfirstlane(tid >> 6), lane = tid & 63, wr = wid >> 2, wc = wid & 3, fr = lane & 15, fq = lane >> 4;
    const int K = g.pitch, nt = g.K / BK;
    unsigned voffA[2], voffB[2];
#pragma unroll
    for (int i = 0; i < 2; ++i) { int R, C; stage_rc(tid * 16 + i * 8192, R, C); const int Rb = (R & ~31) + perm32(R & 31);
        voffA[i] = (unsigned)(R * K + C) * 2u; voffB[i] = (unsigned)(Rb * K + C) * 2u; }
    const size_t kstep = (size_t)(BK * 2);
    const size_t hstep = (size_t)HALF * K * 2;
    const size_t tstep = 2 * hstep;
    const unsigned ldsw = (unsigned)wid * 1024u;
    const int aoff = lds_byte(wr * 64 + fr, fq * 8), boff = lds_byte(wc * 32 + fr, fq * 8);
#define PG8_SA(b, h) (((b) * 2 + (h)) * HTB)
#define PG8_SB(b, h) ((4 + (b) * 2 + (h)) * HTB)
#define PG8_STAGE(bufoff, gbase, voff) do { _Pragma("unroll") for (int _i = 0; _i < 2; ++_i) \
        __builtin_amdgcn_global_load_lds((const PG8_GAS unsigned*)((gbase) + (voff)[_i]), (PG8_LAS unsigned*)(lds + (bufoff) + ldsw + _i * 8192), 16, 0, 0); } while (0)
#define PG8_LDA(dst, b, h) do { _Pragma("unroll") for (int m = 0; m < 4; ++m) _Pragma("unroll") for (int k = 0; k < 2; ++k) dst[m][k] = *(const PG8_LAS bf16x8*)(lds + PG8_SA(b, h) + aoff + m * 2048 + k * 1024); } while (0)
#define PG8_LDB(dst, b, h) do { _Pragma("unroll") for (int n = 0; n < 2; ++n) _Pragma("unroll") for (int k = 0; k < 2; ++k) dst[n][k] = *(const PG8_LAS bf16x8*)(lds + PG8_SB(b, h) + boff + n * 2048 + k * 1024); } while (0)
#define PG8_MMA(ai, bj, At, Bt) do { __builtin_amdgcn_s_setprio(1); if constexpr (F8) { _Pragma("unroll") for (int m = 0; m < 4; ++m) _Pragma("unroll") for (int n = 0; n < 2; ++n) { \
            const v8i_t a8 = __builtin_shufflevector(__builtin_bit_cast(v4i_t, At[m][0]), __builtin_bit_cast(v4i_t, At[m][1]), 0, 1, 2, 3, 4, 5, 6, 7), b8 = __builtin_shufflevector(__builtin_bit_cast(v4i_t, Bt[n][0]), __builtin_bit_cast(v4i_t, Bt[n][1]), 0, 1, 2, 3, 4, 5, 6, 7); \
            asm volatile("v_mfma_scale_f32_16x16x128_f8f6f4 %0, %1, %2, %0, %3, %3 op_sel_hi:[0,0,0]" : "+v"(acc[ai][bj][m][n]) : "v"(b8), "v"(a8), "v"(f8_unit_scale)); } } else { \
        _Pragma("unroll") for (int m = 0; m < 4; ++m) _Pragma("unroll") for (int n = 0; n < 2; ++n) _Pragma("unroll") for (int k = 0; k < 2; ++k) \
        acc[ai][bj][m][n] = __builtin_amdgcn_mfma_f32_16x16x32_bf16(Bt[n][k], At[m][k], acc[ai][bj][m][n], 0, 0, 0); } __builtin_amdgcn_s_setprio(0); } while (0)
#define PG8_WAIT_V(n) asm volatile("s_waitcnt vmcnt(" #n ")" ::: "memory")
#define PG8_WAIT_L(n) asm volatile("s_waitcnt lgkmcnt(" #n ")" ::: "memory")
#define PG8_BAR __builtin_amdgcn_s_barrier()
#define PG8_SCHED __builtin_amdgcn_sched_barrier(0)
    Unit cur, nxt; int ui = 0;
    if (!S.next(0, cur)) return;
    cur.pa = __builtin_amdgcn_readfirstlane(cur.pa); cur.pn = __builtin_amdgcn_readfirstlane(cur.pn); cur.bn = __builtin_amdgcn_readfirstlane(cur.bn); cur.po = __builtin_amdgcn_readfirstlane(cur.po); cur.koff = __builtin_amdgcn_readfirstlane(cur.koff);
    f32x4 acc[2][2][4][2];
    typename Epi::Pre pf;
    const int f8_unit_scale = 0x7F7F7F7F;
    (void)f8_unit_scale;
    if constexpr (Epi::ACC_INIT) E.init(acc, cur, wr, wc, fr, fq);
    else {
#pragma unroll
    for (int a = 0; a < 2; ++a)
#pragma unroll
        for (int b = 0; b < 2; ++b)
#pragma unroll
            for (int m = 0; m < 4; ++m)
#pragma unroll
                for (int n = 0; n < 2; ++n) acc[a][b][m][n] = (f32x4){0.f, 0.f, 0.f, 0.f};
    }
    bf16x8 At[4][2], B0[2][2], B1[2][2];
    const PG8_GAS char* cA = (const PG8_GAS char*)g.A + (size_t)cur.pa * tstep + cur.koff; const PG8_GAS char* cB = (const PG8_GAS char*)g.Bt + (size_t)cur.bn * tstep + cur.koff;
    if constexpr (SP2) {
        PG8_STAGE(PG8_SB(0, 0), cB, voffB); PG8_STAGE(PG8_SB(0, 1), cB + hstep, voffB); PG8_STAGE(PG8_SA(0, 0), cA, voffA); PG8_STAGE(PG8_SA(0, 1), cA + hstep, voffA);
        if (wr == 1) PG8_BAR;
        PG8_WAIT_V(2); PG8_BAR;
        PG8_STAGE(PG8_SB(1, 0), cB + kstep, voffB); PG8_STAGE(PG8_SA(1, 0), cA + kstep, voffA); PG8_STAGE(PG8_SB(1, 1), cB + hstep + kstep, voffB);
        PG8_WAIT_V(6); PG8_BAR;
    } else {
        PG8_STAGE(PG8_SB(0, 0), cB, voffB); PG8_STAGE(PG8_SA(0, 0), cA, voffA); PG8_STAGE(PG8_SB(0, 1), cB + hstep, voffB); PG8_STAGE(PG8_SA(0, 1), cA + hstep, voffA);
        if (wr == 1) PG8_BAR;
        PG8_WAIT_V(4); PG8_BAR;
        PG8_STAGE(PG8_SB(1, 0), cB + kstep, voffB); PG8_STAGE(PG8_SA(1, 0), cA + kstep, voffA); PG8_STAGE(PG8_SB(1, 1), cB + hstep + kstep, voffB);
        PG8_WAIT_V(6); PG8_BAR;
    }
    for (;;) {
        const bool has_next = S.next(ui + 1, nxt);
        nxt.pa = __builtin_amdgcn_readfirstlane(nxt.pa); nxt.pn = __builtin_amdgcn_readfirstlane(nxt.pn); nxt.bn = __builtin_amdgcn_readfirstlane(nxt.bn); nxt.po = __builtin_amdgcn_readfirstlane(nxt.po); nxt.koff = __builtin_amdgcn_readfirstlane(nxt.koff);
        const PG8_GAS char* nA = has_next ? (const PG8_GAS char*)g.A + (size_t)nxt.pa * tstep + nxt.koff : cA; const PG8_GAS char* nB = has_next ? (const PG8_GAS char*)g.Bt + (size_t)nxt.bn * tstep + nxt.koff : cB;
        for (int kh = 0; kh < (Epi::HAS_MID ? 2 : 1); ++kh) {
        const int t_lo = Epi::HAS_MID ? kh * (nt >> 1) : 0, t_hi = Epi::HAS_MID ? (kh + 1) * (nt >> 1) : nt;
#pragma unroll 1
        for (int t = t_lo; t < t_hi; t += 2) {
            const bool last = (t == nt - 2);
            if (last) E.pre(pf, cur, wr, fr);
            const PG8_GAS char* a1 = cA + (size_t)(t + 1) * kstep;
            const PG8_GAS char* a2 = last ? nA : cA + (size_t)(t + 2) * kstep; const PG8_GAS char* b2 = last ? nB : cB + (size_t)(t + 2) * kstep;
            const PG8_GAS char* a3 = a2 + kstep; const PG8_GAS char* b3 = b2 + kstep;
            if constexpr (SP2) {
            PG8_LDB(B0, 0, 0); PG8_LDB(B1, 0, 1); PG8_SCHED; PG8_LDA(At, 0, 0); PG8_STAGE(PG8_SA(1, 1), a1 + hstep, voffA);
            PG8_WAIT_V(8); PG8_WAIT_L(0); PG8_BAR; PG8_MMA(0, 0, At, B0); PG8_MMA(0, 1, At, B1); PG8_BAR; PG8_SCHED;
            PG8_LDA(At, 0, 1); PG8_STAGE(PG8_SB(0, 0), b2, voffB); PG8_STAGE(PG8_SB(0, 1), b2 + hstep, voffB); PG8_STAGE(PG8_SA(0, 0), a2, voffA);
            PG8_WAIT_V(8); PG8_WAIT_L(0); PG8_BAR; PG8_MMA(1, 0, At, B0); PG8_MMA(1, 1, At, B1); PG8_BAR; PG8_SCHED;
            PG8_LDB(B0, 1, 0); PG8_LDB(B1, 1, 1); PG8_SCHED; PG8_LDA(At, 1, 0); PG8_STAGE(PG8_SA(0, 1), a2 + hstep, voffA);
            PG8_WAIT_V(8); PG8_WAIT_L(0); PG8_BAR; PG8_MMA(0, 0, At, B0); PG8_MMA(0, 1, At, B1); PG8_BAR; PG8_SCHED;
            PG8_LDA(At, 1, 1); PG8_STAGE(PG8_SB(1, 0), b3, voffB); PG8_STAGE(PG8_SB(1, 1), b3 + hstep, voffB); PG8_STAGE(PG8_SA(1, 0), a3, voffA);
            PG8_WAIT_V(8); PG8_WAIT_L(0); PG8_BAR; PG8_MMA(1, 0, At, B0); PG8_MMA(1, 1, At, B1); PG8_BAR; PG8_SCHED;
            } else {
            PG8_LDB(B0, 0, 0); PG8_SCHED; PG8_LDA(At, 0, 0); PG8_STAGE(PG8_SA(1, 1), a1 + hstep, voffA);
            PG8_WAIT_L(8); PG8_BAR; PG8_WAIT_L(0); PG8_MMA(0, 0, At, B0); PG8_BAR; PG8_SCHED;
            PG8_LDB(B1, 0, 1); PG8_STAGE(PG8_SB(0, 0), b2, voffB);
            PG8_BAR; PG8_WAIT_L(0); PG8_MMA(0, 1, At, B1); PG8_BAR;
            PG8_LDA(At, 0, 1); PG8_STAGE(PG8_SA(0, 0), a2, voffA);
            PG8_BAR; PG8_WAIT_L(0); PG8_MMA(1, 0, At, B0); PG8_BAR; PG8_SCHED;
            PG8_STAGE(PG8_SB(0, 1), b2 + hstep, voffB);
            PG8_WAIT_V(6); PG8_BAR; PG8_MMA(1, 1, At, B1); PG8_BAR;
            PG8_LDB(B0, 1, 0); PG8_SCHED; PG8_LDA(At, 1, 0); PG8_STAGE(PG8_SA(0, 1), a2 + hstep, voffA);
            PG8_WAIT_L(8); PG8_BAR; PG8_WAIT_L(0); PG8_MMA(0, 0, At, B0); PG8_BAR; PG8_SCHED;
            PG8_LDB(B1, 1, 1); PG8_STAGE(PG8_SB(1, 0), b3, voffB);
            PG8_BAR; PG8_WAIT_L(0); PG8_MMA(0, 1, At, B1); PG8_BAR;
            PG8_LDA(At, 1, 1); PG8_STAGE(PG8_SA(1, 0), a3, voffA);
            PG8_BAR; PG8_WAIT_L(0); PG8_MMA(1, 0, At, B0); PG8_BAR; PG8_SCHED;
            PG8_STAGE(PG8_SB(1, 1), b3 + hstep, voffB);
            PG8_WAIT_V(6); PG8_BAR; PG8_MMA(1, 1, At, B1); PG8_BAR;
            }
        }
        if (Epi::HAS_MID && kh == 0) E.mid(acc, cur, wr, wc, fr, fq);
        }
        if constexpr (ALIGN_EPI) { if (wr == 0) PG8_BAR; }
        E(acc, cur, wr, wc, fr, fq, pf);
        if (!has_next) break;
        if constexpr (Epi::ACC_INIT) E.init(acc, nxt, wr, wc, fr, fq);
        else {
#pragma unroll
        for (int a = 0; a < 2; ++a)
#pragma unroll
            for (int b = 0; b < 2; ++b)
#pragma unroll
                for (int m = 0; m < 4; ++m)
#pragma unroll
                    for (int n = 0; n < 2; ++n) acc[a][b][m][n] = (f32x4){0.f, 0.f, 0.f, 0.f};
        }
        cur = nxt; cA = nA; cB = nB; ++ui;
        if constexpr (ALIGN_EPI) { if (wr == 1) PG8_BAR; }
    }
    PG8_WAIT_V(0);
    if constexpr (!ALIGN_EPI) { if (wr == 0) PG8_BAR; }
    PG8_BAR;
#undef PG8_SA
#undef PG8_SB
#undef PG8_STAGE
#undef PG8_LDA
#undef PG8_LDB
#undef PG8_MMA
#undef PG8_WAIT_V
#undef PG8_WAIT_L
#undef PG8_BAR
#undef PG8_SCHED
}
}

constexpr int NWAVES = 8;
constexpr int S = 16384, D = 1024, DC = 512, NIN = 4608, FF0 = 2816, FFE = 3584, NE = 8;
constexpr int MAXP = 136;
constexpr float RMS_EPS = 1e-6f, LNC_EPS = 1e-5f;

constexpr size_t MiB = 1u << 20;
constexpr size_t WS_CTL = 0, CTL_ZERO_BYTES = 48 * 1024;
constexpr size_t WS_SS = 1 * MiB;
constexpr size_t WS_TOKE = 2 * MiB, WS_TOKW = WS_TOKE + 64 * 1024, WS_TOKR = WS_TOKW + 128 * 1024, WS_TOKS = WS_TOKR + 64 * 1024, WS_CNT = WS_TOKS + 128 * 1024, WS_PS = WS_CNT + 8 * 1024;
constexpr size_t WS_SLOTR = 3 * MiB, WS_SLOTW = WS_SLOTR + 256 * 1024;
constexpr size_t WS_WM13 = 68 * MiB, WS_WM2 = 124 * MiB;
constexpr size_t WS_WL1 = 152 * MiB, WS_WL0 = 165 * MiB;
constexpr size_t WO_IN = 0, WO_AB = 9 * MiB, WO_O = 11 * MiB, WO_13 = 13 * MiB, WO_2 = 24 * MiB;
constexpr size_t WS_XB = 4 * MiB;
constexpr size_t WS_MG = 36 * MiB;
constexpr size_t WS_POOL = 195 * MiB;
constexpr size_t PO_A = 0, PO_V = 16 * MiB, PO_SB = 32 * MiB, PO_R = 48 * MiB, PO_G = 80 * MiB, PO_A2 = 112 * MiB, PO_HID = 144 * MiB, PO_A1 = 232 * MiB, PO_V1 = 248 * MiB;
constexpr size_t WS_XG = 152 * MiB;
constexpr size_t WS_Y = 186 * MiB;
constexpr size_t WS_HC = 254 * MiB;
constexpr size_t WS_PT = 373 * MiB;
constexpr size_t WS_END = 459 * MiB;
static_assert(WS_XG + (size_t)MAXP * 256 * D <= WS_Y && WS_Y + (size_t)MAXP * 256 * D * 2 <= WS_HC && WS_HC + (size_t)MAXP * 256 * FFE <= WS_END && WS_POOL + PO_HID + (size_t)S * FF0 * 2 <= WS_POOL + PO_A1 && WS_POOL + PO_V1 + 16 * MiB <= WS_END && WS_POOL + PO_A2 + 32 * MiB <= WS_POOL + PO_HID, "d_ws map");
static_assert(WS_XB + (size_t)S * D * 2 <= WS_MG && WS_MG + (size_t)S * D * 2 <= WS_WM13 && WS_WL0 + WO_2 + (size_t)D * FF0 * 2 <= WS_POOL && WS_WM2 + (size_t)NE * D * FFE <= WS_WL1 && WS_WM13 + (size_t)NE * 2 * FFE * D <= WS_WM2 && WS_WL1 + 13 * MiB <= WS_WL0, "weight map");
constexpr int CW_BAR = 4096;
constexpr int CW_XID = 1024;
constexpr int CW_TFLAG = 8192;
static_assert((CW_TFLAG + 64 * 32) * 4 <= (int)CTL_ZERO_BYTES, "team flags inside the per-call memset");
constexpr int CW_TEAM = 2048;
static_assert((CW_BAR + 3456) * 4 <= (int)CTL_ZERO_BYTES && CW_TEAM + 64 * 16 <= CW_BAR, "barrier words inside the per-call memset");

constexpr int RING_OFF = 0, RING_BYTES = 131072;
constexpr int LDSCTL_OFF = RING_BYTES, MISC_OFF = LDSCTL_OFF + 320;
constexpr int LDS_BYTES = 147456;

#define GAS __attribute__((address_space(1)))
#define LAS __attribute__((address_space(3)))
typedef unsigned short bf16;
typedef unsigned v4u __attribute__((ext_vector_type(4)));
typedef unsigned v2u __attribute__((ext_vector_type(2)));
typedef int v4i __attribute__((ext_vector_type(4)));
typedef int v2i __attribute__((ext_vector_type(2)));
typedef float f32x4 __attribute__((ext_vector_type(4)));
typedef float f32x2 __attribute__((ext_vector_type(2)));
#define LDS_WAIT() asm volatile("s_waitcnt lgkmcnt(0)" ::: "memory")
#define VM_WAIT() asm volatile("s_waitcnt vmcnt(0)" ::: "memory")
using pg8::cvt_pk_bf16; using pg8::bflo; using pg8::bfhi; using pg8::sigmoid_f;

#define XB_TMO      128
#define XB_XCNT(j)  (256  + 64 * (j))
#define XB_XSUB(j)  (1280 + 64 * (j))
#define XB_XGEN(j)  (2304 + 64 * (j))
#define XB_TOP      3328
#define XB_TOPGEN   3392
#define XCD_BAR_WORDS 3456
#define XB_SPIN_CAP (1u << 18)

__device__ __forceinline__ unsigned xb_ld(unsigned* p)              { return __hip_atomic_load(p, __ATOMIC_RELAXED, __HIP_MEMORY_SCOPE_AGENT); }
__device__ __forceinline__ unsigned xb_add(unsigned* p, unsigned v) { return __hip_atomic_fetch_add(p, v, __ATOMIC_RELAXED, __HIP_MEMORY_SCOPE_AGENT); }
__device__ __forceinline__ unsigned xb_xcc_id() { return (unsigned)__builtin_amdgcn_s_getreg((3 << 11) | 20) & 0xFu; }
#define XB_SPIN(cond, bar) do { unsigned _sp = 0; while (cond) { __builtin_amdgcn_s_sleep(1); \
    if ((++_sp & 255u) == 0u) { if (xb_ld(&(bar)[XB_TMO])) break; if (_sp > XB_SPIN_CAP) { atomicAdd(&(bar)[XB_TMO], 1u); break; } } } } while (0)

struct XcdBarrier {
    unsigned* bar; unsigned x;
    volatile LAS unsigned* st;
};
__device__ __forceinline__ XcdBarrier xcd_barrier_post(unsigned* bar, volatile LAS unsigned* st) {
    XcdBarrier b; b.bar = bar; b.x = xb_xcc_id(); b.st = st;
    if (threadIdx.x == 0) (void)xb_add(&bar[XB_XCNT(b.x)], 1u);
    return b;
}
__device__ __forceinline__ void xcd_barrier_complete(unsigned* bar, unsigned x, unsigned& nloc, unsigned& nx) {
    const unsigned G = gridDim.x * gridDim.y * gridDim.z;
    unsigned sum, cnt, mine, sp = 0u;
    for (;;) {
        sum = 0u; cnt = 0u; mine = 0u;
#pragma unroll
        for (unsigned j = 0; j < 16; ++j) { const unsigned c = xb_ld(&bar[XB_XCNT(j)]); sum += c; cnt += (c > 0u) ? 1u : 0u; mine = (j == x) ? c : mine; }
        if (sum == G) break;
        __builtin_amdgcn_s_sleep(1);
        if ((++sp & 255u) == 0u) { if (xb_ld(&bar[XB_TMO])) break; if (sp > XB_SPIN_CAP) { atomicAdd(&bar[XB_TMO], 1u); break; } }
    }
    nloc = mine > 0u ? mine : 1u; nx = cnt > 0u ? cnt : 1u;
}
__device__ __forceinline__ void xcd_barrier(const XcdBarrier& b) {
    asm volatile("s_waitcnt vmcnt(0)" ::: "memory");
    __syncthreads();
    if (threadIdx.x == 0) {
        unsigned* bar = b.bar;
        __builtin_amdgcn_s_waitcnt(0);
        unsigned nloc = b.st[0], nx = b.st[1];
        if (nloc == 0u) { xcd_barrier_complete(bar, b.x, nloc, nx); b.st[0] = nloc; b.st[1] = nx; }
        const unsigned old = xb_add(&bar[XB_XSUB(b.x)], 1u);
        const unsigned gen = old / nloc;
        if (old + 1u == (gen + 1u) * nloc) {
            __builtin_amdgcn_fence(__ATOMIC_RELEASE, "agent");
            asm volatile("s_waitcnt vmcnt(0)" ::: "memory");
            const unsigned og = xb_add(&bar[XB_TOP], 1u);
            const unsigned tg = og / nx;
            if (og + 1u == (tg + 1u) * nx) xb_add(&bar[XB_TOPGEN], 1u);
            else XB_SPIN(xb_ld(&bar[XB_TOPGEN]) == tg, bar);
            __builtin_amdgcn_fence(__ATOMIC_ACQUIRE, "agent");
            xb_add(&bar[XB_XGEN(b.x)], 1u);
            asm volatile("s_waitcnt vmcnt(0)" ::: "memory");
        } else {
            XB_SPIN(xb_ld(&bar[XB_XGEN(b.x)]) == gen, bar);
            __builtin_amdgcn_fence(__ATOMIC_ACQUIRE, "agent");
            asm volatile("s_waitcnt vmcnt(0)" ::: "memory");
        }
    }
    __syncthreads();
}

__device__ __forceinline__ void team_barrier(unsigned* cnt, unsigned target, bool coloc, unsigned* tmo_bar, unsigned* prev = nullptr) {
    asm volatile("s_waitcnt vmcnt(0)" ::: "memory");
    __syncthreads();
    if (threadIdx.x == 0) {
        __builtin_amdgcn_s_waitcnt(0);
        if (!coloc) { __builtin_amdgcn_fence(__ATOMIC_RELEASE, "agent"); asm volatile("s_waitcnt vmcnt(0)" ::: "memory"); }
        (void)xb_add(cnt, 1u);
        XB_SPIN(xb_ld(cnt) < target, tmo_bar);
        if (prev) XB_SPIN(xb_ld(prev) < target, tmo_bar);
        __builtin_amdgcn_fence(__ATOMIC_ACQUIRE, "agent");
        asm volatile("s_waitcnt vmcnt(0)" ::: "memory");
    }
    __syncthreads();
}
__device__ __forceinline__ void team_barrier_local(unsigned* flags, unsigned member, unsigned seqno, unsigned* tmo_bar) {
    asm volatile("s_waitcnt vmcnt(0)" ::: "memory");
    __syncthreads();
    if (threadIdx.x == 0) {
        __builtin_amdgcn_s_waitcnt(0);
        __hip_atomic_store(flags + member, seqno, __ATOMIC_RELAXED, __HIP_MEMORY_SCOPE_WORKGROUP);
        unsigned sp = 0u;
        for (;;) { const unsigned f0 = xb_ld(flags + 0), f1 = xb_ld(flags + 1), f2 = xb_ld(flags + 2), f3 = xb_ld(flags + 3);
            if (f0 >= seqno && f1 >= seqno && f2 >= seqno && f3 >= seqno) break;
            __builtin_amdgcn_s_sleep(1);
            if ((++sp & 255u) == 0u) { if (xb_ld(&tmo_bar[XB_TMO])) break; if (sp > XB_SPIN_CAP) { atomicAdd(&tmo_bar[XB_TMO], 1u); break; } } }
        __builtin_amdgcn_fence(__ATOMIC_ACQUIRE, "agent");
        asm volatile("s_waitcnt vmcnt(0)" ::: "memory");
    }
    __syncthreads();
}

__device__ __forceinline__ float wave_sum(float v) {
    v += __int_as_float(__builtin_amdgcn_update_dpp(0, __float_as_int(v), 0x111, 0xf, 0xf, true));
    v += __int_as_float(__builtin_amdgcn_update_dpp(0, __float_as_int(v), 0x112, 0xf, 0xf, true));
    v += __int_as_float(__builtin_amdgcn_update_dpp(0, __float_as_int(v), 0x114, 0xf, 0xf, true));
    v += __int_as_float(__builtin_amdgcn_update_dpp(0, __float_as_int(v), 0x118, 0xf, 0xf, true));
    v += __int_as_float(__builtin_amdgcn_update_dpp(0, __float_as_int(v), 0x142, 0xa, 0xf, false));
    v += __int_as_float(__builtin_amdgcn_update_dpp(0, __float_as_int(v), 0x143, 0xc, 0xf, false));
    return __int_as_float(__builtin_amdgcn_readlane(__float_as_int(v), 63));
}
template <bool F8> __device__ __forceinline__ void tr_load(const float* src, int spitch, int scol0, const float* scale, float sc0, int k0, int lane, unsigned (&pa)[F8 ? 16 : 32], unsigned (&pb)[F8 ? 16 : 32]) {
    const int h = lane >> 5, c = lane & 31;
    const float* s = src + (size_t)(k0 + h) * spitch + scol0 + 4 * c;
    f32x4 x[32];
#pragma unroll
    for (int i = 0; i < 32; ++i) x[i] = __builtin_nontemporal_load((const f32x4*)(s + (size_t)(2 * i) * spitch));
    const float sv = scale ? scale[k0 + lane] : 1.0f;
#pragma unroll
    for (int i = 0; i < 32; i += 2) {
        float ea[2], oa[2], eb[2], ob[2];
#pragma unroll
        for (int d = 0; d < 2; ++d) {
            const float s0 = __builtin_bit_cast(float, __builtin_amdgcn_readlane(__builtin_bit_cast(int, sv), 2 * (i + d))), s1 = __builtin_bit_cast(float, __builtin_amdgcn_readlane(__builtin_bit_cast(int, sv), 2 * (i + d) + 1));
            const float sk = (h ? s1 : s0) * sc0;
            const f32x4 y = x[i + d] * sk;
            auto r = __builtin_amdgcn_permlane32_swap(__float_as_uint(y.x), __float_as_uint(y.z), false, false); ea[d] = __uint_as_float(r[0]); oa[d] = __uint_as_float(r[1]);
            auto q = __builtin_amdgcn_permlane32_swap(__float_as_uint(y.y), __float_as_uint(y.w), false, false); eb[d] = __uint_as_float(q[0]); ob[d] = __uint_as_float(q[1]);
        }
        if (F8) { pa[i >> 1] = pg8::pk4_fp8(ea[0], oa[0], ea[1], oa[1]); pb[i >> 1] = pg8::pk4_fp8(eb[0], ob[0], eb[1], ob[1]); }
        else { pa[i] = cvt_pk_bf16(ea[0], oa[0]); pa[i + 1] = cvt_pk_bf16(ea[1], oa[1]); pb[i] = cvt_pk_bf16(eb[0], ob[0]); pb[i + 1] = cvt_pk_bf16(eb[1], ob[1]); }
    }
}
__device__ __forceinline__ void tr_item(const float* src, int spitch, int scol0, const float* scale, bf16* dst, int dpitch, int drow0, int dk0, int k0, int lane, LAS unsigned char* tile) {
    unsigned pa[32], pb[32];
    tr_load<false>(src, spitch, scol0, scale, 1.0f, k0, lane, pa, pb);
    const int ra = 4 * (lane & 31) + 2 * (lane >> 5), sa = (ra >> 1) & 7;
#pragma unroll
    for (int j = 0; j < 8; ++j) {
        *(LAS v4u*)(tile + ra * 128 + ((j ^ sa) << 4)) = (v4u){pa[4 * j], pa[4 * j + 1], pa[4 * j + 2], pa[4 * j + 3]};
        *(LAS v4u*)(tile + (ra + 1) * 128 + ((j ^ sa) << 4)) = (v4u){pb[4 * j], pb[4 * j + 1], pb[4 * j + 2], pb[4 * j + 3]};
    }
#pragma unroll
    for (int jj = 0; jj < 16; ++jj) { const int r = (lane >> 3) + 8 * jj, pc = lane & 7, ch = pc ^ ((r >> 1) & 7);
        const v4u v = *(const LAS v4u*)(tile + r * 128 + (pc << 4));
        *(v4u*)(dst + (size_t)(drow0 + r) * dpitch + dk0 + k0 + 8 * ch) = v; }
}
template <int HALF> __device__ __forceinline__ void tr_item_f8(const float* src, int spitch, int scol0, const float* scale, unsigned char* dst, int dpitch, int drow0, int k0, int lane, LAS unsigned char* tile) {
    const int ra = 4 * (lane & 31) + 2 * (lane >> 5), sa = (ra >> 1) & 7;
#pragma unroll 1
    for (int hf = (HALF < 0 ? 0 : HALF); hf < (HALF < 0 ? 2 : HALF + 1); ++hf) {
        unsigned pa[16], pb[16];
        tr_load<true>(src, spitch, scol0, scale, pg8::F8_WSCALE, k0 + 64 * hf, lane, pa, pb);
#pragma unroll
        for (int j = 0; j < 4; ++j) {
            *(LAS v4u*)(tile + ra * 128 + (((4 * hf + j) ^ sa) << 4)) = (v4u){pa[4 * j], pa[4 * j + 1], pa[4 * j + 2], pa[4 * j + 3]};
            *(LAS v4u*)(tile + (ra + 1) * 128 + (((4 * hf + j) ^ sa) << 4)) = (v4u){pb[4 * j], pb[4 * j + 1], pb[4 * j + 2], pb[4 * j + 3]};
        }
    }
    if (HALF < 0) {
#pragma unroll
        for (int jj = 0; jj < 16; ++jj) { const int r = (lane >> 3) + 8 * jj, pc = lane & 7, ch = pc ^ ((r >> 1) & 7);
            const v4u v = *(const LAS v4u*)(tile + r * 128 + (pc << 4));
            *(v4u*)(dst + (size_t)(drow0 + r) * dpitch + k0 + 16 * ch) = v; }
    } else {
#pragma unroll
        for (int jj = 0; jj < 8; ++jj) { const int r = (lane >> 2) + 16 * jj, ch = 4 * HALF + (lane & 3), pc = ch ^ ((r >> 1) & 7);
            const v4u v = *(const LAS v4u*)(tile + r * 128 + (pc << 4));
            *(v4u*)(dst + (size_t)(drow0 + r) * dpitch + k0 + 16 * ch) = v; }
    }
}

struct Args { const float* in[31]; float* out; unsigned char* ws; int ph_lo, ph_hi; };

constexpr int I_IN = 36 * 16, I_A = 8 * 8, I_O = 8 * 16, I_MIX = I_IN + 2 * I_A + I_O, I_13 = 44 * 16, I_2 = 8 * 44, I_M13 = 56 * 8, I_M2 = 8 * 28;
__device__ __forceinline__ void wt_item(const Args& a, int it, int lane, LAS unsigned char* tile) {
    unsigned char* ws = a.ws;
    int r = it;
    if (r < 2 * I_MIX) {
        const int L = r / I_MIX; r -= L * I_MIX;
        unsigned char* wl = ws + (L ? WS_WL1 : WS_WL0);
        if (r < I_IN) {
            const int kb = r / 36, nb = r % 36, u = nb >> 1, bj = nb & 1;
            int col0;
            if (u < 4) col0 = (bj ? 512 : 0) + 128 * u;
            else if (u < 8) col0 = (bj ? 2048 : 1536) + 128 * (u - 4);
            else if (u < 10) col0 = 1024 + 256 * (u - 8) + 128 * bj;
            else col0 = (bj ? 3584 : 2560) + 128 * (u - 10);
            tr_item(L ? a.in[16] : a.in[2], NIN, col0, L ? a.in[15] : a.in[1], (bf16*)(wl + WO_IN), D, nb * 128, 0, kb * 64, lane, tile);
        } else if (r < I_IN + I_A) { r -= I_IN; const int kb = r / 8, nb = r % 8;
            tr_item(L ? a.in[21] : a.in[7], D, nb * 128, nullptr, (bf16*)(wl + WO_AB), D, nb * 128, 0, kb * 64, lane, tile);
        } else if (r < I_IN + 2 * I_A) { r -= I_IN + I_A; const int kb = r / 8, nb = r % 8;
            tr_item(L ? a.in[23] : a.in[9], D, nb * 128, nullptr, (bf16*)(wl + WO_AB), D, nb * 128, DC, kb * 64, lane, tile);
        } else { r -= I_IN + 2 * I_A; const int kb = r / 8, nb = r % 8;
            tr_item(L ? a.in[24] : a.in[10], D, nb * 128, nullptr, (bf16*)(wl + WO_O), D, nb * 128, 0, kb * 64, lane, tile);
        }
        return;
    }
    r -= 2 * I_MIX;
    if (r < I_13) {
        const int kb = r / 44, nb = r % 44, u = nb >> 1, bj = nb & 1;
        tr_item(bj ? a.in[13] : a.in[12], FF0, 128 * u, a.in[11], (bf16*)(ws + WS_WL0 + WO_13), D, nb * 128, 0, kb * 64, lane, tile);
        return;
    }
    r -= I_13;
    if (r < I_2) { const int kb = r / 8, nb = r % 8;
        tr_item(a.in[14], D, nb * 128, nullptr, (bf16*)(ws + WS_WL0 + WO_2), FF0, nb * 128, 0, kb * 64, lane, tile);
        return;
    }
}
constexpr int N_MOE_ITEMS = NE * (I_M13 + I_M2), N_DENSE_ITEMS = 2 * I_MIX + I_13 + I_2;
constexpr int SLOT_Q = 3, SLOT_EXTRA_WGS = 0, N_SLOT_ITEMS = 512 * SLOT_Q + SLOT_EXTRA_WGS * 4;
constexpr int N_MOE_P0 = N_MOE_ITEMS - 3 * N_SLOT_ITEMS;
template <int HALF> __device__ __forceinline__ void moe_item(const Args& a, int r, int lane, LAS unsigned char* tile) {
    unsigned char* ws = a.ws;
    if (r < NE * I_M13) {
        const int e = r / I_M13; r -= e * I_M13;
        const int kb = r / 56, nb = r % 56, u = nb >> 1, bj = nb & 1;
        tr_item_f8<HALF>((bj ? a.in[28] : a.in[27]) + (size_t)e * D * FFE, FFE, 128 * u, a.in[25], ws + WS_WM13 + (size_t)e * 2 * FFE * D, D, nb * 128, kb * 128, lane, tile);
        return;
    }
    r -= NE * I_M13;
    { const int e = r / I_M2; r -= e * I_M2; const int kb = r / 8, nb = r % 8;
      tr_item_f8<HALF>(a.in[29] + (size_t)e * FFE * D, D, nb * 128, nullptr, ws + WS_WM2 + (size_t)e * D * FFE, FFE, nb * 128, kb * 128, lane, tile); }
}
#define MOE_SLOT(s) do { if (G == 256 && bid >= 128) { \
        for (int q_ = 0; q_ < SLOT_Q + ((bid >= 256 - SLOT_EXTRA_WGS) ? 1 : 0); ++q_) { \
            const int it_ = N_MOE_P0 + (s) * N_SLOT_ITEMS + (q_ < SLOT_Q ? q_ * 512 + (bid - 128) * (NWAVES / 2) : SLOT_Q * 512 + (bid - (256 - SLOT_EXTRA_WGS)) * (NWAVES / 2)) + (wave >> 1); \
            if (wave & 1) moe_item<1>(args, it_, lane, lds + RING_OFF + wave * 16384); else moe_item<0>(args, it_, lane, lds + RING_OFF + wave * 16384); } } } while (0)

__global__ void __launch_bounds__(NWAVES * 64, 2) fwd(Args args) {
    extern __shared__ __attribute__((aligned(16))) unsigned char lds_raw[];
    LAS unsigned char* lds = (LAS unsigned char*)lds_raw;
    volatile LAS unsigned* MISC = (volatile LAS unsigned*)(lds + MISC_OFF);
    const int tid = threadIdx.x, lane = tid & 63, wave = __builtin_amdgcn_readfirstlane(tid >> 6);
    const int G = gridDim.x; const int vcu = (G % 8 == 0) ? ((int)blockIdx.x % 8) * (G / 8) + (int)blockIdx.x / 8 : (int)blockIdx.x;
    unsigned char* const ws = args.ws;
    unsigned* const ctl = (unsigned*)(ws + WS_CTL);
    for (int u = tid; u < (LDS_BYTES - LDSCTL_OFF) / 4; u += NWAVES * 64) ((LAS unsigned*)(lds + LDSCTL_OFF))[u] = 0u;
    __syncthreads();
    XcdBarrier bar; bar.bar = ctl + CW_BAR; bar.x = 0; bar.st = nullptr;
    if (!MK_PER_PHASE) bar = xcd_barrier_post(ctl + CW_BAR, MISC + 8);
    if (!MK_PER_PHASE && threadIdx.x == 0) __hip_atomic_store(ctl + CW_XID + blockIdx.x, bar.x + 1u, __ATOMIC_RELAXED, __HIP_MEMORY_SCOPE_AGENT);
    const int lo = args.ph_lo, hi = args.ph_hi;
#ifndef PH_MASK
#define PH_MASK 0xFFFFu
#endif
#define IN(k) (((PH_MASK >> (k)) & 1u) && lo <= (k) && (k) < hi)
#ifndef REP_MASK
#define REP_MASK 0u
#endif
#define REPS(k) (1 + (int)((REP_MASK >> (k)) & 1u))
#define SEAM(k) do { if (IN((k) + 1)) { if (MK_PER_PHASE) { if (tid == 0) __hip_atomic_store(ctl + 0, 0xBADBA0u, __ATOMIC_RELAXED, __HIP_MEMORY_SCOPE_AGENT); } else xcd_barrier(bar); } } while (0)
#define TEAM_CHECK() do { if (!MK_PER_PHASE && (threadIdx.x >> 6) == 0) { const int ln_ = (int)threadIdx.x & 63, pa_ = 8 * ((int)blockIdx.x & 7) + (((int)blockIdx.x >> 3) & 7); unsigned v_ = bar.x + 1u; \
        if (ln_ < 8) { const int b0_ = 8 * ((pa_ + 1) & 7) + ((pa_ + 1) >> 3); v_ = xb_ld(ctl + CW_XID + (ln_ < 4 ? ((int)blockIdx.x & 63) + 64 * ln_ : (pa_ < 63 ? b0_ + 64 * (ln_ - 4) : (int)blockIdx.x))); }     \
        const unsigned long long m_ = __ballot(v_ == bar.x + 1u); if (ln_ == 0) { MISC[12] = ((m_ & 0xFull) == 0xFull) ? 1u : 0u; MISC[13] = ((m_ & 0xFFull) == 0xFFull) ? 1u : 0u; } } } while (0)
#define TEAM_SEAM(k, seq) do { if (IN((k) + 1)) { if (!MK_PER_PHASE && G == 256) { unsigned* const c_ = ctl + CW_TEAM + 16 * (8 * ((int)blockIdx.x & 7) + (((int)blockIdx.x >> 3) & 7)); if (MISC[12] != 0u) team_barrier_local(ctl + CW_TFLAG + 32 * (8 * ((int)blockIdx.x & 7) + (((int)blockIdx.x >> 3) & 7)), (unsigned)blockIdx.x >> 6, (unsigned)(seq) + 1u, ctl + CW_BAR); else team_barrier(c_, 4u * ((unsigned)(seq) + 1u), false, ctl + CW_BAR); } else SEAM(k); } } while (0)
#define TEAM_SEAM_NB(k, seq) do { if (IN((k) + 1)) { if (!MK_PER_PHASE && G == 256) { const int pa_ = 8 * ((int)blockIdx.x & 7) + (((int)blockIdx.x >> 3) & 7); team_barrier(ctl + CW_TEAM + 16 * pa_ + 4, 4u * ((unsigned)(seq) + 1u), MISC[13] != 0u, ctl + CW_BAR, pa_ > 0 ? ctl + CW_TEAM + 16 * (pa_ - 1) + 4 : nullptr); } else SEAM(k); } } while (0)
    const int gw = vcu * NWAVES + wave, NGW = G * NWAVES;
    const int vr = (G == 256) ? 4 * (8 * ((int)blockIdx.x & 7) + (((int)blockIdx.x >> 3) & 7)) + ((int)blockIdx.x >> 6) : vcu;
#define PHASE_PTRS() GAS unsigned char* wsp = (GAS unsigned char*)ws; asm volatile("" : "+s"(wsp)); int bid = (int)blockIdx.x; asm volatile("" : "+s"(bid)); (void)bid; int tidp_ = (int)threadIdx.x; asm volatile("" : "+v"(tidp_)); const int tid = tidp_, lane = tid & 63; (void)tid; (void)lane; float* const ssb = (float*)(wsp + WS_SS); bf16* const XB = (bf16*)(wsp + WS_XB); \
    GAS unsigned char* const pool = wsp + WS_POOL; (void)ssb; (void)XB; (void)pool

#define RSTD_TABLE(pa) do { LAS float* rt_ = (LAS float*)(lds + LDSCTL_OFF + 1024); if (tid < 256) { const f32x4* p_ = (const f32x4*)(ssb + ((size_t)(pa) * 256 + tid) * 16); \
        const f32x4 a_ = p_[0], b_ = p_[1], c_ = p_[2], d_ = p_[3]; const float s_ = (((a_.x + a_.y) + (a_.z + a_.w)) + ((b_.x + b_.y) + (b_.z + b_.w))) + (((c_.x + c_.y) + (c_.z + c_.w)) + ((d_.x + d_.y) + (d_.z + d_.w))); \
        rt_[tid] = __builtin_amdgcn_rsqf(s_ * (1.0f / 1024.0f) + 1e-6f); } __syncthreads(); } while (0)
    const LAS float* const RTAB = (const LAS float*)(lds + LDSCTL_OFF + 1024);

    if (IN(0)) {
        PHASE_PTRS();
        for (int rep_ = 0; rep_ < REPS(0); ++rep_)
        if (G == 256 && N_MOE_P0 == 768 && N_DENSE_ITEMS >= 2560 && N_DENSE_ITEMS <= 2816) {
            LAS unsigned char* const til = lds + RING_OFF + wave * 16384;
#pragma unroll 1
            for (int st = 0; st < 2; ++st) {
                int kind = 0, idx = 0;
                if (wave < 3) { if (st == 0) { kind = 1; idx = wave * 256 + bid; } else if (wave == 0 && 2560 + bid < N_DENSE_ITEMS) { kind = 2; idx = 2560 + bid; } }
                else { kind = 2; idx = ((wave - 3) + 5 * st) * 256 + bid; }
                if (kind == 1) moe_item<-1>(args, idx, lane, til); else if (kind == 2) wt_item(args, idx, lane, til);
            }
        } else
        for (int it = gw; it < N_DENSE_ITEMS + N_MOE_P0; it += NGW) { if (it < N_DENSE_ITEMS) wt_item(args, it, lane, lds + RING_OFF + wave * 16384); else moe_item<-1>(args, it - N_DENSE_ITEMS, lane, lds + RING_OFF + wave * 16384); }
        const float* x = args.in[0];
        for (int m0 = gw; m0 < S; m0 += 4 * NGW) {
            f32x4 v[4][4];
#pragma unroll
            for (int b = 0; b < 4; ++b) { const f32x4* xr = (const f32x4*)(x + (size_t)(m0 + b * NGW) * D) + lane;
#pragma unroll
                for (int j = 0; j < 4; ++j) v[b][j] = __builtin_nontemporal_load(xr + 64 * j); }
#pragma unroll
            for (int b = 0; b < 4; ++b) {
                const int m = m0 + b * NGW; float s = 0.f;
#pragma unroll
                for (int j = 0; j < 4; ++j) s += (v[b][j].x * v[b][j].x + v[b][j].y * v[b][j].y) + (v[b][j].z * v[b][j].z + v[b][j].w * v[b][j].w);
                s = wave_sum(s);
                v2u* o8 = (v2u*)(XB + (size_t)m * D) + lane;
#pragma unroll
                for (int j = 0; j < 4; ++j) { v2u w; w.x = cvt_pk_bf16(v[b][j].x, v[b][j].y); w.y = cvt_pk_bf16(v[b][j].z, v[b][j].w); o8[64 * j] = w; }
                if (lane < 16) ssb[(size_t)m * 16 + lane] = (lane == 0) ? s : 0.f;
            }
        }
        SEAM(0);
        TEAM_CHECK();
    }

    for (int layer = 0; layer < 2; ++layer) {
        const int pb = 1 + 6 * layer;
        if (IN(pb)) {
            PHASE_PTRS(); GAS unsigned char* const wl = wsp + (layer ? WS_WL1 : WS_WL0); (void)wl;
            pg8::Gemm g{XB, (const bf16*)(wl + WO_IN), D, D};
            int pa0; { pg8::StaticOrder S0; S0.init(S / 256, 10, G, bid, 0); pg8::Unit u0; pa0 = S0.next(0, u0) ? u0.pa : 0; }
            RSTD_TABLE(pa0);
            for (int rep_ = 0; rep_ < REPS(1); ++rep_)
            { pg8::StaticOrder So; So.init(S / 256, 10, G, bid, 0);
              pg8::EpiG1<0> E{ssb, (bf16*)(pool + (layer ? PO_A1 : PO_A)), (bf16*)(pool + (layer ? PO_V1 : PO_V)), (bf16*)(pool + PO_SB), (bf16*)(pool + PO_R), (bf16*)(pool + PO_G), RTAB, pa0};
              pg8::gemm_phase<pg8::EpiG1<0>, pg8::StaticOrder, true, true>(lds + RING_OFF, g, So, E); }
            for (int rep_ = 0; rep_ < REPS(20); ++rep_)
            { pg8::StaticOrder So; So.init(S / 256, 8, G, bid, 10);
              pg8::EpiG1<1> E{ssb, (bf16*)(pool + (layer ? PO_A1 : PO_A)), (bf16*)(pool + (layer ? PO_V1 : PO_V)), (bf16*)(pool + PO_SB), (bf16*)(pool + PO_R), (bf16*)(pool + PO_G), RTAB, pa0};
              pg8::gemm_phase<pg8::EpiG1<1>, pg8::StaticOrder, true, true>(lds + RING_OFF, g, So, E); }
            if (layer == 0) MOE_SLOT(0); else MOE_SLOT(2);
            TEAM_SEAM_NB(pb, layer ? 1 : 0);
        }
        if (IN(pb + 1)) {
            PHASE_PTRS(); GAS unsigned char* const wl = wsp + (layer ? WS_WL1 : WS_WL0); (void)wl;
            const float* conv_a = layer ? args.in[17] : args.in[3]; const float* conv_ab = layer ? args.in[18] : args.in[4];
            const float* ln_g = layer ? args.in[19] : args.in[5]; const float* ln_b = layer ? args.in[20] : args.in[6]; const float* conv_b = layer ? args.in[22] : args.in[8];
            const bf16* abuf = (const bf16*)(pool + (layer ? PO_A1 : PO_A)); const bf16* vbuf = (const bf16*)(pool + (layer ? PO_V1 : PO_V)); const bf16* sbuf = (const bf16*)(pool + PO_SB); bf16* A2 = (bf16*)(pool + PO_A2);
            volatile LAS float* pst = (volatile LAS float*)(lds + RING_OFF);
            LAS float* wl31 = (LAS float*)(lds + RING_OFF + 65536);
            const int cq = tid & 127, oct = tid >> 7;
            { f32x4 tw[8];
#pragma unroll
              for (int i = 0; i < 8; ++i) { const int idx = tid + NWAVES * 64 * i; tw[i] = ((const f32x4*)conv_a)[idx < 31 * DC / 4 ? idx : 31 * DC / 4 - 1]; }
#pragma unroll
              for (int i = 0; i < 8; ++i) { const int idx = tid + NWAVES * 64 * i; if (idx < 31 * DC / 4) ((LAS f32x4*)wl31)[idx] = tw[i]; } }
            f32x4 wb[3];
#pragma unroll
            for (int j = 0; j < 3; ++j) wb[j] = *(const f32x4*)(conv_b + j * DC + 4 * cq);
            const f32x4 cbias = *(const f32x4*)(conv_ab + 4 * cq);
            const f32x4 gq = *(const f32x4*)(ln_g + 4 * cq), bq = *(const f32x4*)(ln_b + 4 * cq);
            __syncthreads();
            int ctile0 = vcu, cstep = G;
            if (G == 256) { ctile0 = 8 * (8 * (bid & 7) + ((bid >> 3) & 7)) + 2 * (bid >> 6); cstep = 1; }
            for (int rep_ = 0; rep_ < REPS(2); ++rep_)
            for (int tile = ctile0, tcount = 0; (G == 256) ? (tcount < 2) : (tile < S / 32); tile += cstep, ++tcount) {
                const int tb = tile * 32 + oct * 8;
                f32x4 acc8[8]; float st1[8], st2[8];
                {
                    v2u in[38];
                    const bool interior = __builtin_amdgcn_readfirstlane(tb) >= 30;
                    if (interior) {
#pragma unroll
                        for (int i = 0; i < 38; ++i) in[i] = *(const v2u*)(abuf + (size_t)(tb - 30 + i) * DC + 4 * cq);
                    } else {
#pragma unroll
                        for (int i = 0; i < 38; ++i) { const int r = tb - 30 + i; in[i] = (r >= 0) ? *(const v2u*)(abuf + (size_t)r * DC + 4 * cq) : (v2u){0u, 0u}; }
                    }
                    v2u vin[10], sv[8];
                    if (interior) {
#pragma unroll
                        for (int i = 0; i < 10; ++i) vin[i] = *(const v2u*)(vbuf + (size_t)(tb - 2 + i) * DC + 4 * cq);
                    } else {
#pragma unroll
                        for (int i = 0; i < 10; ++i) { const int r = tb - 2 + i; vin[i] = (r >= 0) ? *(const v2u*)(vbuf + (size_t)r * DC + 4 * cq) : (v2u){0u, 0u}; }
                    }
#pragma unroll
                    for (int o = 0; o < 8; ++o) sv[o] = *(const v2u*)(sbuf + (size_t)(tb + o) * DC + 4 * cq);
#pragma unroll
                    for (int o = 0; o < 8; ++o) acc8[o] = cbias;
#pragma unroll
                    for (int j = 0; j < 31; ++j) { const f32x4 w = *(const LAS f32x4*)(wl31 + j * DC + 4 * cq);
#pragma unroll
                        for (int o = 0; o < 8; ++o) { const v2u x = in[o + j]; acc8[o] += (f32x4){bflo(x.x), bfhi(x.x), bflo(x.y), bfhi(x.y)} * w; } }
                    {
                        float ps1[8], ps2[8];
#pragma unroll
                        for (int o = 0; o < 8; ++o) { const f32x4 a = acc8[o]; ps1[o] = wave_sum((a.x + a.y) + (a.z + a.w)); ps2[o] = wave_sum((a.x * a.x + a.y * a.y) + (a.z * a.z + a.w * a.w)); }
                        if (lane == 0) {
#pragma unroll
                            for (int o = 0; o < 8; ++o) { pst[(tcount & 1) * 256 + (wave * 8 + o) * 2] = ps1[o]; pst[(tcount & 1) * 256 + (wave * 8 + o) * 2 + 1] = ps2[o]; } }
#pragma unroll
                        for (int o = 0; o < 8; ++o) { st1[o] = ps1[o]; st2[o] = ps2[o]; }
                    }
#pragma unroll
                    for (int o = 0; o < 8; ++o) {
                        f32x4 u = (f32x4){0.f, 0.f, 0.f, 0.f};
#pragma unroll
                        for (int j = 0; j < 3; ++j) { const v2u x = vin[o + j]; u += (f32x4){bflo(x.x), bfhi(x.x), bflo(x.y), bfhi(x.y)} * wb[j]; }
                        const v2u s = sv[o]; v2u w; w.x = cvt_pk_bf16(bflo(s.x) * u.x, bfhi(s.x) * u.y); w.y = cvt_pk_bf16(bflo(s.y) * u.z, bfhi(s.y) * u.w);
                        *(v2u*)(A2 + (size_t)(tb + o) * D + DC + 4 * cq) = w;
                    }
                }
                __syncthreads();
#pragma unroll
                for (int o = 0; o < 8; ++o) {
                    const float q1 = pst[(tcount & 1) * 256 + ((wave ^ 1) * 8 + o) * 2], q2 = pst[(tcount & 1) * 256 + ((wave ^ 1) * 8 + o) * 2 + 1];
                    const float mean = (st1[o] + q1) * (1.f / DC), var = fmaxf((st2[o] + q2) * (1.f / DC) - mean * mean, 0.f);
                    const float rstd = __builtin_amdgcn_rsqf(var + LNC_EPS);
                    f32x4 y = (acc8[o] - mean) * rstd * gq + bq;
#pragma unroll
                    for (int j = 0; j < 4; ++j) y[j] = y[j] * sigmoid_f(y[j]);
                    v2u w; w.x = cvt_pk_bf16(y.x, y.y); w.y = cvt_pk_bf16(y.z, y.w);
                    *(v2u*)(A2 + (size_t)(tb + o) * D + 4 * cq) = w;
                }
            }
            TEAM_SEAM(pb + 1, layer ? 5 : 0);
        }
        if (IN(pb + 2)) {
            PHASE_PTRS(); GAS unsigned char* const wl = wsp + (layer ? WS_WL1 : WS_WL0); (void)wl;
            pg8::StaticOrder So; So.init(S / 256, D / 256, G, bid);
            pg8::Gemm g{(const bf16*)(pool + PO_A2), (const bf16*)(wl + WO_AB), D, D};
            pg8::EpiG2 E{(const bf16*)(pool + PO_R), (const bf16*)(pool + PO_G), (bf16*)(wsp + WS_MG)};
            for (int rep_ = 0; rep_ < REPS(3); ++rep_)
            pg8::gemm_phase<pg8::EpiG2, pg8::StaticOrder, true, true>(lds + RING_OFF, g, So, E);
            TEAM_SEAM(pb + 2, layer ? 6 : 1);
        }
        if (IN(pb + 3)) {
            PHASE_PTRS(); GAS unsigned char* const wl = wsp + (layer ? WS_WL1 : WS_WL0); (void)wl;
            pg8::Gemm g{(const bf16*)(wsp + WS_MG), (const bf16*)(wl + WO_O), D, D}; pg8::StaticOrder So; So.init(S / 256, D / 256, G, bid);
            if (layer == 0) { pg8::EpiRes<true, false> E{nullptr, XB, ssb};
                pg8::gemm_phase<pg8::EpiRes<true, false>, pg8::StaticOrder, true, true>(lds + RING_OFF, g, So, E); }
            else { pg8::EpiRes<false, false> E{nullptr, XB, ssb};
                pg8::gemm_phase<pg8::EpiRes<false, false>, pg8::StaticOrder, true, true>(lds + RING_OFF, g, So, E); }
            TEAM_SEAM(pb + 3, layer ? 7 : 2);
        }
        if (layer == 0) {
            if (IN(5)) {
                PHASE_PTRS();
                pg8::Gemm g{XB, (const bf16*)(wsp + WS_WL0 + WO_13), D, D}; pg8::StaticOrder So; So.init(S / 256, 2 * FF0 / 256, G, bid);
                int pa0; { pg8::Unit u0; pa0 = So.next(0, u0) ? u0.pa : 0; }
                RSTD_TABLE(pa0);
                pg8::EpiUp<false> E{ssb, (bf16*)(pool + PO_HID), FF0, RTAB, pa0};
                for (int rep_ = 0; rep_ < REPS(5); ++rep_)
                pg8::gemm_phase<pg8::EpiUp<false>, pg8::StaticOrder, true, true>(lds + RING_OFF, g, So, E);
                MOE_SLOT(1);
                TEAM_SEAM(5, 3);
            }
            if (IN(6)) {
                PHASE_PTRS();
                pg8::Gemm g{(const bf16*)(pool + PO_HID), (const bf16*)(wsp + WS_WL0 + WO_2), FF0, FF0}; pg8::StaticOrder So; So.init(S / 256, D / 256, G, bid);
                pg8::EpiRes<true, false> E{nullptr, XB, ssb};
                pg8::gemm_phase<pg8::EpiRes<true, false>, pg8::StaticOrder, true, true>(lds + RING_OFF, g, So, E);
                TEAM_SEAM(6, 4);
            }
        }
    }

#define MOE_PTRS() PHASE_PTRS(); unsigned* const tok_e = (unsigned*)(wsp + WS_TOKE); f32x2* const tok_w = (f32x2*)(wsp + WS_TOKW); float* const tok_r = (float*)(wsp + WS_TOKR); v2i* const tok_s = (v2i*)(wsp + WS_TOKS); \
    int* const cntg = (int*)(wsp + WS_CNT); int* const psg = (int*)(wsp + WS_PS); float* const slot_r = (float*)(wsp + WS_SLOTR); float* const slot_w = (float*)(wsp + WS_SLOTW); \
    unsigned char* const XG = (unsigned char*)(wsp + WS_XG); unsigned char* const HC = (unsigned char*)(wsp + WS_HC); unsigned char* const Y = (unsigned char*)(wsp + WS_Y); (void)Y; unsigned char* const PT = (unsigned char*)(wsp + WS_PT); (void)PT; (void)tok_e; (void)tok_w; (void)tok_r; (void)tok_s; (void)cntg; (void)psg; (void)slot_r; (void)slot_w; (void)XG; (void)HC

    if (IN(11)) {
        MOE_PTRS();
        LAS float* rgA = (LAS float*)(lds + RING_OFF);
        LAS float* rgB = rgA + 4096;
        LAS int* hist = (LAS int*)(lds + RING_OFF + 32768);
        const float* router = args.in[26]; const float* g2 = args.in[25];
        v2u xrow[8][4];
#pragma unroll
        for (int b = 0; b < 8; ++b) { const v2u* xr_ = (const v2u*)(XB + (size_t)(vr * 64 + wave * 8 + b) * D) + lane;
#pragma unroll
            for (int j = 0; j < 4; ++j) xrow[b][j] = xr_[64 * j]; }
        { f32x4 rv[4]; float gk[4];
#pragma unroll
          for (int i4 = 0; i4 < 4; ++i4) { const int q = tid + 512 * i4; rv[i4] = ((const f32x4*)router)[q]; gk[i4] = g2[q >> 1]; }
#pragma unroll
          for (int i4 = 0; i4 < 4; ++i4) { const int q = tid + 512 * i4, k = q >> 1, jj = k >> 8, ln = (k & 255) >> 2, ii = k & 3;
              *(LAS f32x4*)(((q & 1) ? rgB : rgA) + ((jj * 4 + ii) * 64 + ln) * 4) = rv[i4] * gk[i4]; } }
        if (tid < 8) hist[tid] = 0;
        __syncthreads();
        float ac[8][8], sqv[8];
#pragma unroll
        for (int b = 0; b < 8; ++b) { sqv[b] = 0.f;
#pragma unroll
            for (int e = 0; e < 8; ++e) ac[b][e] = 0.f; }
#pragma unroll
        for (int j = 0; j < 4; ++j)
#pragma unroll
            for (int i = 0; i < 4; ++i) {
                const f32x4 ra = *(const LAS f32x4*)(rgA + ((j * 4 + i) * 64 + lane) * 4), rb = *(const LAS f32x4*)(rgB + ((j * 4 + i) * 64 + lane) * 4);
#pragma unroll
                for (int b = 0; b < 8; ++b) { const v2u xp = xrow[b][j]; const float xx = (i == 0) ? bflo(xp.x) : (i == 1) ? bfhi(xp.x) : (i == 2) ? bflo(xp.y) : bfhi(xp.y);
                    sqv[b] += xx * xx;
                    ac[b][0] += xx * ra.x; ac[b][1] += xx * ra.y; ac[b][2] += xx * ra.z; ac[b][3] += xx * ra.w; ac[b][4] += xx * rb.x; ac[b][5] += xx * rb.y; ac[b][6] += xx * rb.z; ac[b][7] += xx * rb.w; }
                if (i == 3) __builtin_amdgcn_sched_barrier(0); }
        float r4[4][9], r2[2][9], r1[9];
        { const bool h = (lane & 32) != 0;
#pragma unroll
          for (int i = 0; i < 4; ++i)
#pragma unroll
              for (int q = 0; q < 9; ++q) { const float lo = (q < 8) ? ac[i][q < 8 ? q : 0] : sqv[i], hi = (q < 8) ? ac[i + 4][q < 8 ? q : 0] : sqv[i + 4];
                  const auto sw = __builtin_amdgcn_permlane32_swap(__float_as_uint(lo), __float_as_uint(hi), false, false);
                  r4[i][q] = __uint_as_float(sw[0]) + __uint_as_float(sw[1]); (void)h; } }
        { const bool h = (lane & 16) != 0;
#pragma unroll
          for (int i = 0; i < 2; ++i)
#pragma unroll
              for (int q = 0; q < 9; ++q) { const auto sw = __builtin_amdgcn_permlane16_swap(__float_as_uint(r4[i][q]), __float_as_uint(r4[i + 2][q]), false, false);
                  r2[i][q] = __uint_as_float(sw[0]) + __uint_as_float(sw[1]); (void)h; } }
        { const bool h = (lane & 8) != 0;
#pragma unroll
          for (int q = 0; q < 9; ++q) r1[q] = (h ? r2[1][q] : r2[0][q]) + __shfl_xor(h ? r2[0][q] : r2[1][q], 8); }
#pragma unroll
        for (int q = 0; q < 9; ++q) {
            r1[q] += __int_as_float(__builtin_amdgcn_update_dpp(0, __float_as_int(r1[q]), 0xB1, 0xf, 0xf, true));
            r1[q] += __int_as_float(__builtin_amdgcn_update_dpp(0, __float_as_int(r1[q]), 0x4E, 0xf, 0xf, true));
            r1[q] += __int_as_float(__builtin_amdgcn_update_dpp(0, __float_as_int(r1[q]), 0x141, 0xf, 0xf, true)); }
        {
            const int t = vr * 64 + wave * 8 + ((lane >> 3) & 7);
            const float rstd = __builtin_amdgcn_rsqf(r1[8] * (1.f / D) + RMS_EPS);
            int e0 = 0; float l0 = r1[0];
#pragma unroll
            for (int e = 1; e < 8; ++e) if (r1[e] > l0) { l0 = r1[e]; e0 = e; }
            int e1 = -1; float l1 = 0.f;
#pragma unroll
            for (int e = 0; e < 8; ++e) if (e != e0 && (e1 < 0 || r1[e] > l1)) { l1 = r1[e]; e1 = e; }
            const float w0 = 1.0f / (1.0f + __expf((l1 - l0) * rstd)), w1 = 1.0f - w0;
            if ((lane & 7) == 0) { tok_e[t] = (unsigned)e0 | ((unsigned)e1 << 8); tok_w[t] = (f32x2){w0, w1}; tok_r[t] = rstd; __hip_atomic_fetch_add(&hist[e0], 1, __ATOMIC_RELAXED, __HIP_MEMORY_SCOPE_WORKGROUP); __hip_atomic_fetch_add(&hist[e1], 1, __ATOMIC_RELAXED, __HIP_MEMORY_SCOPE_WORKGROUP); }
        }
        __syncthreads();
        if (tid < 8) cntg[vr * 8 + tid] = hist[tid];
        __syncthreads();
        SEAM(11);
    }
    if (IN(12)) {
        MOE_PTRS();
        LAS int* sh = (LAS int*)(lds + RING_OFF);
        v4u xr8[8][2];
#pragma unroll
        for (int tk = 0; tk < 8; ++tk) { const v4u* xr = (const v4u*)(XB + (size_t)(vr * 64 + wave * 8 + tk) * D) + 2 * lane; xr8[tk][0] = xr[0]; xr8[tk][1] = xr[1]; }
        {
            v4i c0 = (v4i){0, 0, 0, 0}, c1 = c0;
            if (tid < G) { c0 = *(const v4i*)(cntg + tid * 8); c1 = *(const v4i*)(cntg + tid * 8 + 4); }
            const int c[8] = {c0.x, c0.y, c0.z, c0.w, c1.x, c1.y, c1.z, c1.w};
#pragma unroll
            for (int e = 0; e < 8; ++e) { int a = c[e], b = (tid < vr) ? c[e] : 0;
#pragma unroll
                for (int o = 1; o < 64; o <<= 1) { a += __shfl_xor(a, o); b += __shfl_xor(b, o); }
                if (lane == 0) { sh[256 + wave * 16 + e] = a; sh[256 + wave * 16 + 8 + e] = b; } }
        }
        __syncthreads();
        if (tid == 0) { int p = 0;
            for (int e = 0; e < 8; ++e) { int T = 0, P = 0; for (int w = 0; w < NWAVES; ++w) { T += sh[256 + w * 16 + e]; P += sh[256 + w * 16 + 8 + e]; }
                sh[e] = T; sh[16 + e] = p; sh[32 + e] = 256 * p + P; p += (T + 255) >> 8; }
            sh[24] = p;
            if (vr == 0) { for (int e = 0; e < 9; ++e) psg[e] = sh[16 + e]; } }
        __syncthreads();
        if (wave == 0) {
            const int t = vr * 64 + lane; const unsigned ee = tok_e[t]; const int e0 = ee & 255, e1 = ee >> 8; int s0 = 0, s1 = 0;
            const unsigned long long below = (1ull << lane) - 1ull;
#pragma unroll
            for (int e = 0; e < 8; ++e) { const unsigned long long mk = __ballot((e0 == e) || (e1 == e)); const int rank = __popcll(mk & below); const int o = sh[32 + e] + rank; if (e0 == e) s0 = o; if (e1 == e) s1 = o; }
            tok_s[t] = (v2i){s0, s1}; sh[64 + 2 * lane] = s0; sh[64 + 2 * lane + 1] = s1;
            const f32x2 w = tok_w[t]; const float rs = tok_r[t];
            slot_r[s0] = rs; slot_r[s1] = rs; slot_w[s0] = w.x; slot_w[s1] = w.y;
        }
        __syncthreads();
#pragma unroll
        for (int tk = 0; tk < 8; ++tk) {
            const int i = wave * 8 + tk; const int s0 = sh[64 + 2 * i], s1 = sh[64 + 2 * i + 1];
            const v4u a = xr8[tk][0], b = xr8[tk][1]; v4u w;
            w.x = pg8::pk4_fp8(bflo(a.x), bfhi(a.x), bflo(a.y), bfhi(a.y)); w.y = pg8::pk4_fp8(bflo(a.z), bfhi(a.z), bflo(a.w), bfhi(a.w));
            w.z = pg8::pk4_fp8(bflo(b.x), bfhi(b.x), bflo(b.y), bfhi(b.y)); w.w = pg8::pk4_fp8(bflo(b.z), bfhi(b.z), bflo(b.w), bfhi(b.w));
            *((v4u*)(XG + (size_t)s0 * D) + lane) = w; *((v4u*)(XG + (size_t)s1 * D) + lane) = w;
        }
        for (int e = 0; e < 8; ++e) {
            const int tot = sh[e], base = 256 * sh[16 + e] + tot, npad = 256 * (sh[16 + e + 1] - sh[16 + e]) - tot;
            for (int pr = vcu; pr < npad; pr += G) { const int row = base + pr;
                if (tid < 64) ((v4u*)(XG + (size_t)row * D))[tid] = (v4u){0u, 0u, 0u, 0u};
                if (tid == 0) { slot_r[row] = 0.f; slot_w[row] = 0.f; } }
        }
        __syncthreads();
        SEAM(12);
    }
    {
        const int pu = 13;
        if (IN(pu) || IN(pu + 1)) {
            MOE_PTRS();
            int psv = (lane < 9) ? psg[lane] : 0;
            pg8::MoeOrder<true> Su; pg8::MoeOrder<false> Sd;
#pragma unroll
            for (int e = 0; e < 9; ++e) { Su.ps[e] = __builtin_amdgcn_readlane(psv, e); Sd.ps[e] = Su.ps[e]; }
            const int NP = Su.ps[8];
            if (IN(pu)) {
                Su.p_lo = 0; Su.np = NP; Su.nN = 2 * FFE / 256; Su.nwg = NP * Su.nN; Su.G = G; Su.c = bid;
                pg8::Gemm g{(const bf16*)XG, (const bf16*)(wsp + WS_WM13), D / 2, D / 2};
                pg8::EpiUp<true> E{slot_r, HC, FFE, nullptr, 0};
                for (int rep_ = 0; rep_ < REPS(pu); ++rep_)
                pg8::gemm_phase<pg8::EpiUp<true>, pg8::MoeOrder<true>, true, true, true>(lds + RING_OFF, g, Su, E);
                SEAM(pu);
            }
            if (IN(pu + 1)) {
                const int npm = NP < pg8::TAIL_P0 ? NP : pg8::TAIL_P0;
                Sd.p_lo = 0; Sd.np = npm; Sd.nN = D / 256; Sd.nwg = npm * Sd.nN; Sd.G = G; Sd.c = bid;
                pg8::MoeTailOrder St; St.ntail = NP - npm; St.G = G; St.c = bid;
#pragma unroll
                for (int e = 0; e < 9; ++e) St.ps[e] = Sd.ps[e];
                for (int rep_ = 0; rep_ < REPS(pu + 1); ++rep_) {
                { pg8::Gemm g{(const bf16*)HC, (const bf16*)(wsp + WS_WM2), FFE / 2, FFE / 2};
                  pg8::EpiDownMoeT<false> E{slot_w, Y};
                  pg8::gemm_phase<pg8::EpiDownMoeT<false>, pg8::MoeOrder<false>, true, true, true>(lds + RING_OFF, g, Sd, E); }
                { pg8::Gemm g{(const bf16*)HC, (const bf16*)(wsp + WS_WM2), 256, FFE / 2};
                  pg8::EpiDownMoeT<true> E{slot_w, PT};
                  pg8::gemm_phase<pg8::EpiDownMoeT<true>, pg8::MoeTailOrder, true, true, true>(lds + RING_OFF, g, St, E); }
                }
                SEAM(pu + 1);
            }
        }
    }
    if (IN(15)) {
        MOE_PTRS();
        const float* gf = args.in[30]; float* out = args.out;
        f32x4 gv[4];
#pragma unroll
        for (int j = 0; j < 4; ++j) gv[j] = *((const f32x4*)gf + lane + 64 * j);
        for (int rep_ = 0; rep_ < REPS(15); ++rep_)
        for (int m0 = gw; m0 < S; m0 += 4 * NGW) {
            v2i sl[4];
#pragma unroll
            for (int b = 0; b < 4; ++b) sl[b] = tok_s[m0 + b * NGW];
            v2u xa[4][4]; unsigned ya[4][2][4];
#pragma unroll
            for (int b = 0; b < 4; ++b) {
                const v2u* xr = (const v2u*)(XB + (size_t)(m0 + b * NGW) * D) + lane;
#pragma unroll
                for (int j = 0; j < 4; ++j) xa[b][j] = xr[64 * j];
#pragma unroll
                for (int q = 0; q < 2; ++q) { const int sq = q ? sl[b].y : sl[b].x; const unsigned* y = (const unsigned*)(Y + (size_t)(sq < pg8::TAIL_P0 * 256 ? sq : 0) * D) + lane;
#pragma unroll
                    for (int j = 0; j < 4; ++j) ya[b][q][j] = y[64 * j]; }
            }
#pragma unroll
            for (int b = 0; b < 4; ++b) {
                const int m = m0 + b * NGW;
                f32x4 v[4]; float s = 0.f;
#pragma unroll
                for (int j = 0; j < 4; ++j) { const v2u a = xa[b][j]; v[j] = (f32x4){bflo(a.x), bfhi(a.x), bflo(a.y), bfhi(a.y)}; }
#pragma unroll
                for (int q = 0; q < 2; ++q) {
                    const int sq = q ? sl[b].y : sl[b].x;
                    if (sq < pg8::TAIL_P0 * 256) {
#pragma unroll
                        for (int j = 0; j < 4; ++j) { const unsigned a = ya[b][q][j]; const f32x2 lo = __builtin_amdgcn_cvt_pk_f32_fp8((int)a, false), hi = __builtin_amdgcn_cvt_pk_f32_fp8((int)a, true);
                            v[j].x += lo.x * pg8::Y8_INV; v[j].y += lo.y * pg8::Y8_INV; v[j].z += hi.x * pg8::Y8_INV; v[j].w += hi.y * pg8::Y8_INV; }
                    } else {
                        const int pl = (sq >> 8) - pg8::TAIL_P0, r = sq & 255;
                        for (int ks = 0; ks < pg8::TAIL_NKS; ++ks) { const unsigned* y = (const unsigned*)(PT + ((size_t)(ks * 8 + pl) * 256 + r) * D) + lane;
#pragma unroll
                            for (int j = 0; j < 4; ++j) { const unsigned a = y[64 * j]; const f32x2 lo = __builtin_amdgcn_cvt_pk_f32_fp8((int)a, false), hi = __builtin_amdgcn_cvt_pk_f32_fp8((int)a, true);
                                v[j].x += lo.x * pg8::Y8_INV; v[j].y += lo.y * pg8::Y8_INV; v[j].z += hi.x * pg8::Y8_INV; v[j].w += hi.y * pg8::Y8_INV; } }
                    }
                }
#pragma unroll
                for (int j = 0; j < 4; ++j) s += (v[j].x * v[j].x + v[j].y * v[j].y) + (v[j].z * v[j].z + v[j].w * v[j].w);
                const float rstd = __builtin_amdgcn_rsqf(wave_sum(s) * (1.f / D) + RMS_EPS);
                f32x4* o = (f32x4*)(out + (size_t)m * D) + lane;
#pragma unroll
                for (int j = 0; j < 4; ++j) __builtin_nontemporal_store(v[j] * rstd * gv[j], o + 64 * j);
            }
        }
    }
#undef IN
#undef SEAM
}

constexpr int N_PHASES = 16;
extern "C" void kernel_launch(void* const* d_in, const int* in_sizes, int n_in, void* d_out, int out_size, void* d_ws, size_t ws_size, hipStream_t stream) {
    static int grid = 0;
    if (grid == 0) {
        if (n_in != 31 || in_sizes[0] != S * D || out_size != S * D || ws_size < WS_END) { fprintf(stderr, "kernel_launch: unexpected shapes (n_in %d, in0 %d, out %d, ws %zu < %zu); nothing launched\n", n_in, n_in > 0 ? in_sizes[0] : -1, out_size, ws_size, (size_t)WS_END); grid = -1; return; }
        int dev = 0, cus = 0, per_cu = 0;
        if (hipGetDevice(&dev) != hipSuccess || hipDeviceGetAttribute(&cus, hipDeviceAttributeMultiprocessorCount, dev) != hipSuccess) { grid = -1; return; }
        if (hipFuncSetAttribute((const void*)fwd, hipFuncAttributeMaxDynamicSharedMemorySize, LDS_BYTES) != hipSuccess) { fprintf(stderr, "kernel_launch: hipFuncSetAttribute failed\n"); grid = -1; return; }
        if (hipOccupancyMaxActiveBlocksPerMultiprocessor(&per_cu, (const void*)fwd, NWAVES * 64, LDS_BYTES) != hipSuccess || per_cu < 1) fprintf(stderr, "kernel_launch: occupancy query reports %d workgroups per CU\n", per_cu);
        (void)hipGetLastError();
        grid = cus;
        if (grid > 256) grid = 256;
    }
    if (grid < 0) return;
    if (hipMemsetAsync((char*)d_ws + WS_CTL, 0, CTL_ZERO_BYTES, stream) != hipSuccess) return;
    Args a{};
    for (int i = 0; i < 31; ++i) a.in[i] = (const float*)d_in[i];
    a.out = (float*)d_out; a.ws = (unsigned char*)d_ws;
#if MK_PER_PHASE
    for (int p = 0; p < N_PHASES; ++p) { a.ph_lo = p; a.ph_hi = p + 1; hipLaunchKernelGGL(fwd, dim3(grid), dim3(NWAVES * 64), LDS_BYTES, stream, a); }
#else
    a.ph_lo = 0; a.ph_hi = N_PHASES;
    hipLaunchKernelGGL(fwd, dim3(grid), dim3(NWAVES * 64), LDS_BYTES, stream, a);
#endif
}
```
